# Optimizing an MI355X kernel written in HIP

```python
import math
import jax, jax.numpy as jnp
from jax import lax
import numpy as np

D_MODEL = 2048
BATCH = 2
SEQ = 8192
DEPTH = 4

GRID_W = 64
CTX_LEN = 256
N_MIXERS = 4
GROUP_WIDTH = D_MODEL // N_MIXERS
MIX_WIDTH = N_MIXERS * GROUP_WIDTH
HEAD_DIM = 128
GROUP_HEADS = GROUP_WIDTH // HEAD_DIM
GDN_CONV = 3
GDN_CHUNK = 64
DIFF_SUB = HEAD_DIM // 2
MLA_Q_RANK = 384
MLA_KV_RANK = 128
MLA_NOPE = 128
MLA_ROPE = 64
NA_KR = 8
NA_KC = 16
D_FF = 5632
FFN_CONV = 3
ROPE_THETA = 10000.0
Q_BLOCK = 128
LN_EPS = 1e-5
RMS_EPS = 1e-6
DEEPNORM_ALPHA = (2 * DEPTH) ** 0.25
DEEPNORM_BETA = (8 * DEPTH) ** -0.25
GDN_COLS = 4 * GROUP_WIDTH + 4 * GROUP_HEADS
DIFF_COLS = 3 * GROUP_WIDTH
MLA_COLS = MLA_Q_RANK + MLA_KV_RANK + MLA_ROPE
NA_COLS = 3 * GROUP_WIDTH
N_IN = GDN_COLS + DIFF_COLS + MLA_COLS + NA_COLS

kernel_name = 'hybrid_parallel_heads_dit_trunk'


def _layernorm(x, g, b):
    xf = x.astype(jnp.float32)
    mu = jnp.mean(xf, -1, keepdims=True)
    var = jnp.mean(jnp.square(xf - mu), -1, keepdims=True)
    return ((xf - mu) * lax.rsqrt(var + LN_EPS) * g + b).astype(x.dtype)


def _rmsnorm(x, g):
    xf = x.astype(jnp.float32)
    return (xf * lax.rsqrt(jnp.mean(jnp.square(xf), -1, keepdims=True) + RMS_EPS) * g).astype(x.dtype)


def _l2norm(x):
    xf = x.astype(jnp.float32)
    return xf * lax.rsqrt(jnp.sum(jnp.square(xf), -1, keepdims=True) + RMS_EPS)


def _softmax_f32(s):
    return jax.nn.softmax(s.astype(jnp.float32), axis=-1)


def _dwconv(x, w):
    k = w.shape[0]
    pad = k // 2
    n = x.shape[1]
    xp = jnp.pad(x, ((0, 0), (pad, pad), (0, 0)))
    return sum(xp[:, i:i + n] * w[i] for i in range(k))


def _rope_1d(x, pos):
    d = x.shape[-1]
    inv = ROPE_THETA ** (-jnp.arange(0, d, 2, dtype=jnp.float32) / d)
    ang = pos[:, None] * inv[None, :]
    cos = jnp.cos(ang).astype(x.dtype)
    sin = jnp.sin(ang).astype(x.dtype)
    x1, x2 = jnp.split(x, 2, axis=-1)
    return jnp.concatenate([x1 * cos - x2 * sin, x1 * sin + x2 * cos], axis=-1)


def _rope_2d(x, row, col):
    xa, xb = jnp.split(x, 2, axis=-1)
    return jnp.concatenate([_rope_1d(xa, row), _rope_1d(xb, col)], axis=-1)


def _split_heads(t):
    b, n, _ = t.shape
    return t.reshape(b, n, GROUP_HEADS, -1).transpose(0, 2, 1, 3)


def _merge_heads(o):
    b, h, n, d = o.shape
    return o.transpose(0, 2, 1, 3).reshape(b, n, h * d)


def _sweep_query_blocks(fn, *qs):
    b, h, n = qs[0].shape[:3]
    nb = n // Q_BLOCK
    blocks = tuple(jnp.moveaxis(q.reshape(b, h, nb, Q_BLOCK, q.shape[-1]), 2, 0) for q in qs)
    out = lax.map(lambda qb: fn(*qb), blocks)
    return jnp.moveaxis(out, 0, 2).reshape(b, h, n, out.shape[-1])


def _dense_attend(q, k, v, scale):
    p = _softmax_f32(jnp.einsum('bhqd,bhkd->bhqk', q, k) * scale).astype(v.dtype)
    return jnp.einsum('bhqk,bhkd->bhqd', p, v)


def _gated_delta_chunked(q, k, v, log_a, beta, s0):
    b, h, n, dk = q.shape
    dv = v.shape[-1]
    nc = n // GDN_CHUNK
    cs = GDN_CHUNK
    ch = lambda t: t.reshape(b, h, nc, cs, *t.shape[3:])
    q, k, v, log_a, beta = ch(q), ch(k), ch(v), ch(log_a), ch(beta)
    g = jnp.cumsum(log_a, axis=-1)
    incl = jnp.tril(jnp.ones((cs, cs), bool))
    strict = jnp.tril(jnp.ones((cs, cs), bool), -1)
    decay = jnp.exp(jnp.where(incl, g[..., :, None] - g[..., None, :], -jnp.inf))
    kb = k * beta[..., None]
    a_mat = jnp.where(strict, jnp.einsum('bhnid,bhnjd->bhnij', kb, k) * decay, 0.0)
    eye = jnp.broadcast_to(jnp.eye(cs, dtype=q.dtype), a_mat.shape)
    t_inv = lax.linalg.triangular_solve(eye + a_mat, eye, left_side=True, lower=True, unit_diagonal=True)
    w = jnp.einsum('bhnij,bhnjd->bhnid', t_inv, kb * jnp.exp(g)[..., None])
    u = jnp.einsum('bhnij,bhnjd->bhnid', t_inv, v * beta[..., None])
    qk = jnp.where(incl, jnp.einsum('bhnid,bhnjd->bhnij', q, k) * decay, 0.0)

    def step(s, xs):
        q_i, k_i, w_i, u_i, g_i, qk_i = xs
        v_new = u_i - jnp.einsum('bhcd,bhdv->bhcv', w_i, s)
        o = (jnp.einsum('bhcd,bhdv->bhcv', q_i * jnp.exp(g_i)[..., None], s)
             + jnp.einsum('bhij,bhjv->bhiv', qk_i, v_new))
        g_last = g_i[..., -1]
        s = (s * jnp.exp(g_last)[..., None, None]
             + jnp.einsum('bhcd,bhcv->bhdv', k_i * jnp.exp(g_last[..., None] - g_i)[..., None], v_new))
        return s, o

    xs = tuple(jnp.moveaxis(t, 2, 0) for t in (q, k, w, u, g, qk))
    s_fin, o = lax.scan(step, s0, xs)
    return jnp.moveaxis(o, 0, 2).reshape(b, h, n, dv), s_fin


def _gdn_mixer(p, pc, conv_w, a_log, dt_bias, norm_g, with_ctx_out):
    wd = GROUP_WIDTH

    def prep(t):
        b, n, _ = t.shape
        q, k, v = jnp.split(jax.nn.silu(_dwconv(t[..., :3 * wd], conv_w)).astype(jnp.float32), 3, axis=-1)
        q = _l2norm(_split_heads(q)) * HEAD_DIM ** -0.5
        k = _l2norm(_split_heads(k))
        v = _split_heads(v)
        ab = t[..., 4 * wd:].astype(jnp.float32).reshape(b, n, 2, 2, GROUP_HEADS)
        log_a = -jnp.exp(a_log.astype(jnp.float32)) * jax.nn.softplus(ab[:, :, 0] + dt_bias.astype(jnp.float32))
        beta = jax.nn.sigmoid(ab[:, :, 1])
        return q, k, v, t[..., 3 * wd:4 * wd], log_a.transpose(2, 0, 3, 1), beta.transpose(2, 0, 3, 1)

    ql, kl, vl, zl, lal, btl = prep(p)
    qc, kc, vc, zc, lac, btc = prep(pc)
    b = p.shape[0]
    out_l = 0.0
    out_c = 0.0
    for d in range(2):
        f = (lambda t: jnp.flip(t, axis=2)) if d == 1 else (lambda t: t)
        s0 = jnp.zeros((b, GROUP_HEADS, HEAD_DIM, HEAD_DIM), jnp.float32)
        oc, s_ctx = _gated_delta_chunked(f(qc), f(kc), f(vc), f(lac[d]), f(btc[d]), s0)
        ol, _ = _gated_delta_chunked(f(ql), f(kl), f(vl), f(lal[d]), f(btl[d]), s_ctx)
        out_l = out_l + f(ol)
        out_c = out_c + f(oc)

    def finish(o, z):
        o = _rmsnorm(o.transpose(0, 2, 1, 3), norm_g)
        b_, n_ = o.shape[:2]
        return (o.reshape(b_, n_, GROUP_WIDTH) * jax.nn.silu(z.astype(jnp.float32))).astype(z.dtype)

    return finish(out_l, zl), (finish(out_c, zc) if with_ctx_out else None)


def _diff_mixer(p, pc, lam_qk, norm_g, layer_idx, row, col, with_ctx_out):
    wd = GROUP_WIDTH
    lam_init = 0.8 - 0.6 * math.exp(-0.3 * layer_idx)
    lf = lam_qk.astype(jnp.float32)
    lam = jnp.exp(jnp.sum(lf[0] * lf[1])) - jnp.exp(jnp.sum(lf[2] * lf[3])) + lam_init
    scale = DIFF_SUB ** -0.5

    def heads(t, rope):
        b, n, _ = t.shape
        q = t[..., :wd].reshape(b, n, GROUP_HEADS, 2, DIFF_SUB).transpose(3, 0, 2, 1, 4)
        k = t[..., wd:2 * wd].reshape(b, n, GROUP_HEADS, 2, DIFF_SUB).transpose(3, 0, 2, 1, 4)
        v = _split_heads(t[..., 2 * wd:3 * wd])
        if rope:
            q = _rope_2d(q, row, col)
            k = _rope_2d(k, row, col)
        return q, k, v

    ql, kl, vl = heads(p, True)
    qc, kc, vc = heads(pc, False)

    def attend(k1, k2, vv):
        def fn(q1b, q2b):
            p1 = _softmax_f32(jnp.einsum('bhqd,bhkd->bhqk', q1b, k1) * scale)
            p2 = _softmax_f32(jnp.einsum('bhqd,bhkd->bhqk', q2b, k2) * scale)
            return jnp.einsum('bhqk,bhkd->bhqd', (p1 - lam * p2).astype(vv.dtype), vv)
        return fn

    k1 = jnp.concatenate([kc[0], kl[0]], axis=2)
    k2 = jnp.concatenate([kc[1], kl[1]], axis=2)
    v_all = jnp.concatenate([vc, vl], axis=2)
    o_l = _sweep_query_blocks(attend(k1, k2, v_all), ql[0], ql[1])

    def finish(o):
        o = _rmsnorm(o.transpose(0, 2, 1, 3), norm_g) * (1.0 - lam_init)
        b_, n_ = o.shape[:2]
        return o.reshape(b_, n_, GROUP_WIDTH)

    y_c = finish(attend(kc[0], kc[1], vc)(qc[0], qc[1])) if with_ctx_out else None
    return finish(o_l), y_c


def _mla_mixer(p, pc, q_norm_g, kv_norm_g, w_uq, w_ukv, row, col, with_ctx_out):
    scale = (MLA_NOPE + MLA_ROPE) ** -0.5

    def heads(t, rope):
        b, n, _ = t.shape
        c_q = _rmsnorm(t[..., :MLA_Q_RANK], q_norm_g)
        c_kv = _rmsnorm(t[..., MLA_Q_RANK:MLA_Q_RANK + MLA_KV_RANK], kv_norm_g)
        k_r = t[..., MLA_Q_RANK + MLA_KV_RANK:][:, None]
        q = _split_heads(c_q @ w_uq)
        kv = _split_heads(c_kv @ w_ukv)
        q_n, q_r = q[..., :MLA_NOPE], q[..., MLA_NOPE:]
        k_n, v = kv[..., :MLA_NOPE], kv[..., MLA_NOPE:]
        if rope:
            q_r = _rope_2d(q_r, row, col)
            k_r = _rope_2d(k_r, row, col)
        q = jnp.concatenate([q_n, q_r], axis=-1)
        k = jnp.concatenate([k_n, jnp.broadcast_to(k_r, (b, GROUP_HEADS, n, MLA_ROPE))], axis=-1)
        return q, k, v

    ql, kl, vl = heads(p, True)
    qc, kc, vc = heads(pc, False)
    k_all = jnp.concatenate([kc, kl], axis=2)
    v_all = jnp.concatenate([vc, vl], axis=2)
    o_l = _sweep_query_blocks(lambda qb: _dense_attend(qb, k_all, v_all, scale), ql)
    y_c = _merge_heads(_dense_attend(qc, kc, vc, scale)) if with_ctx_out else None
    return _merge_heads(o_l), y_c


def _na_mixer(p, pc, rpb, with_ctx_out):
    wd = GROUP_WIDTH
    scale = HEAD_DIM ** -0.5
    ql, kl, vl = [_split_heads(p[..., i * wd:(i + 1) * wd]) for i in range(3)]
    qc, kc, vc = [_split_heads(pc[..., i * wd:(i + 1) * wd]) for i in range(3)]
    b, h, n, d = ql.shape
    rows = n // GRID_W
    kr = min(NA_KR, rows)
    grid = lambda t: t.reshape(b, h, rows, GRID_W, d)
    qg, kg, vg = grid(ql), grid(kl), grid(vl)
    r = jnp.arange(rows)
    row_idx = jnp.clip(r - kr // 2, 0, rows - kr)[:, None] + jnp.arange(kr)[None, :]
    k_nb = jnp.take(kg, row_idx, axis=2)
    v_nb = jnp.take(vg, row_idx, axis=2)
    cq = jnp.arange(GRID_W)
    col_start = jnp.clip(cq - NA_KC // 2, 0, GRID_W - NA_KC)
    col_ok = (cq[None, :] >= col_start[:, None]) & (cq[None, :] < col_start[:, None] + NA_KC)
    dy = row_idx - r[:, None] + (NA_KR - 1)
    dx = jnp.clip(cq[None, :] - cq[:, None] + (NA_KC - 1), 0, 2 * NA_KC - 2)
    bias = rpb[:, dy[:, None, :, None], dx[None, :, None, :]]
    s_nb = jnp.einsum('bhrqd,bhrikd->bhrqik', qg, k_nb).astype(jnp.float32) * scale + bias
    s_nb = jnp.where(col_ok[:, None, :], s_nb, -jnp.inf)
    s_ctx = jnp.einsum('bhrqd,bhcd->bhrqc', qg, kc).astype(jnp.float32) * scale
    n_nb = kr * GRID_W
    probs = jax.nn.softmax(jnp.concatenate([s_nb.reshape(b, h, rows, GRID_W, n_nb), s_ctx], axis=-1), axis=-1)
    probs = probs.astype(vl.dtype)
    o = (jnp.einsum('bhrqik,bhrikd->bhrqd', probs[..., :n_nb].reshape(b, h, rows, GRID_W, kr, GRID_W), v_nb)
         + jnp.einsum('bhrqc,bhcd->bhrqd', probs[..., n_nb:], vc))
    y_l = _merge_heads(o.reshape(b, h, n, d))
    y_c = _merge_heads(_dense_attend(qc, kc, vc, scale)) if with_ctx_out else None
    return y_l, y_c


def _conv_ffn(h, w_up, conv_w, w_down):
    gate, val = jnp.split(_dwconv(h @ w_up, conv_w), 2, axis=-1)
    return (jax.nn.silu(gate) * val) @ w_down


def setup_inputs(seed: int = 0) -> dict:
    key = jax.random.key(seed)
    ks = iter(jax.random.split(key, 40))
    f32 = jnp.float32
    nrm = lambda shape, s: jax.random.normal(next(ks), shape, f32) * s
    dt = jnp.exp(jax.random.uniform(next(ks), (DEPTH, 2, GROUP_HEADS), f32,
                                    minval=math.log(1e-3), maxval=math.log(1e-1)))
    return {
        'x': nrm((BATCH, SEQ, D_MODEL), 1.0),
        'c': nrm((BATCH, D_MODEL), 1.0),
        'ctx': nrm((BATCH, CTX_LEN, D_MODEL), 1.0),
        'c_ctx': nrm((D_MODEL,), 1.0),
        'w_mod': nrm((DEPTH, D_MODEL, 6 * D_MODEL), 0.5 * D_MODEL ** -0.5),
        'b_mod': nrm((DEPTH, 6 * D_MODEL), 0.02),
        'w_in': nrm((DEPTH, D_MODEL, N_IN), D_MODEL ** -0.5),
        'gdn_conv': nrm((DEPTH, GDN_CONV, 3 * GROUP_WIDTH), GDN_CONV ** -0.5),
        'gdn_a_log': jnp.log(jax.random.uniform(next(ks), (DEPTH, 2, GROUP_HEADS), f32, minval=1.0, maxval=16.0)),
        'gdn_dt_bias': dt + jnp.log(-jnp.expm1(-dt)),
        'gdn_norm_g': 1.0 + nrm((DEPTH, HEAD_DIM), 0.02),
        'diff_lambda': nrm((DEPTH, 4, DIFF_SUB), 0.1),
        'diff_norm_g': 1.0 + nrm((DEPTH, HEAD_DIM), 0.02),
        'mla_q_norm_g': 1.0 + nrm((DEPTH, MLA_Q_RANK), 0.02),
        'mla_kv_norm_g': 1.0 + nrm((DEPTH, MLA_KV_RANK), 0.02),
        'mla_w_uq': nrm((DEPTH, MLA_Q_RANK, GROUP_HEADS * (MLA_NOPE + MLA_ROPE)), MLA_Q_RANK ** -0.5),
        'mla_w_ukv': nrm((DEPTH, MLA_KV_RANK, GROUP_HEADS * (MLA_NOPE + HEAD_DIM)), MLA_KV_RANK ** -0.5),
        'na_rpb': nrm((DEPTH, GROUP_HEADS, 2 * NA_KR - 1, 2 * NA_KC - 1), 0.1),
        'w_out': nrm((DEPTH, MIX_WIDTH, D_MODEL), DEEPNORM_BETA * MIX_WIDTH ** -0.5),
        'ln_g': 1.0 + nrm((DEPTH, 2, D_MODEL), 0.02),
        'ln_b': nrm((DEPTH, 2, D_MODEL), 0.02),
        'ffn_w_up': nrm((DEPTH, D_MODEL, 2 * D_FF), D_MODEL ** -0.5),
        'ffn_conv': nrm((DEPTH, FFN_CONV, 2 * D_FF), FFN_CONV ** -0.5),
        'ffn_w_down': nrm((DEPTH, D_FF, D_MODEL), DEEPNORM_BETA * D_FF ** -0.5),
    }


def reference(x, c, ctx, c_ctx, w_mod, b_mod, w_in, gdn_conv, gdn_a_log, gdn_dt_bias, gdn_norm_g,
              diff_lambda, diff_norm_g, mla_q_norm_g, mla_kv_norm_g, mla_w_uq, mla_w_ukv,
              na_rpb, w_out, ln_g, ln_b, ffn_w_up, ffn_conv, ffn_w_down):
    n_lat = x.shape[1]
    pos = jnp.arange(n_lat)
    row = (pos // GRID_W).astype(jnp.float32)
    col = (pos % GRID_W).astype(jnp.float32)
    s_c = jax.nn.silu(c)
    s_cc = jax.nn.silu(c_ctx)
    o_gdn = GDN_COLS
    o_diff = GDN_COLS + DIFF_COLS
    o_mla = GDN_COLS + DIFF_COLS + MLA_COLS
    xc = ctx
    for l in range(DEPTH):
        ctx_out = l < DEPTH - 1
        m = [t[:, None] for t in jnp.split(s_c @ w_mod[l] + b_mod[l], 6, axis=-1)]
        mc = jnp.split(s_cc @ w_mod[l] + b_mod[l], 6, axis=-1)
        h = x * (1 + m[1]) + m[0]
        hc = xc * (1 + mc[1]) + mc[0]
        p = h @ w_in[l]
        pc = hc @ w_in[l]
        ya, yca = _gdn_mixer(p[..., :o_gdn], pc[..., :o_gdn], gdn_conv[l], gdn_a_log[l], gdn_dt_bias[l],
                             gdn_norm_g[l], ctx_out)
        yb, ycb = _diff_mixer(p[..., o_gdn:o_diff], pc[..., o_gdn:o_diff], diff_lambda[l], diff_norm_g[l],
                              l, row, col, ctx_out)
        ym, ycm = _mla_mixer(p[..., o_diff:o_mla], pc[..., o_diff:o_mla], mla_q_norm_g[l], mla_kv_norm_g[l],
                             mla_w_uq[l], mla_w_ukv[l], row, col, ctx_out)
        yn, ycn = _na_mixer(p[..., o_mla:], pc[..., o_mla:], na_rpb[l], ctx_out)
        y = jnp.concatenate([ya, yb, ym, yn], axis=-1) @ w_out[l]
        x = _layernorm(DEEPNORM_ALPHA * x + m[2] * y, ln_g[l, 0], ln_b[l, 0])
        h = x * (1 + m[4]) + m[3]
        x = _layernorm(DEEPNORM_ALPHA * x + m[5] * _conv_ffn(h, ffn_w_up[l], ffn_conv[l], ffn_w_down[l]),
                       ln_g[l, 1], ln_b[l, 1])
        if ctx_out:
            yc = jnp.concatenate([yca, ycb, ycm, ycn], axis=-1) @ w_out[l]
            xc = _layernorm(DEEPNORM_ALPHA * xc + mc[2] * yc, ln_g[l, 0], ln_b[l, 0])
            hc = xc * (1 + mc[4]) + mc[3]
            xc = _layernorm(DEEPNORM_ALPHA * xc + mc[5] * _conv_ffn(hc, ffn_w_up[l], ffn_conv[l], ffn_w_down[l]),
                            ln_g[l, 1], ln_b[l, 1])
    return x
```

```cpp
#include <hip/hip_runtime.h>
#include <cstdio>
#include <cstdint>

#ifndef MK_FUSED
#define MK_FUSED 1
#endif

#define DI __device__ __forceinline__
#define LAS __attribute__((address_space(3)))
typedef unsigned short bf16_t;
typedef short bf16x8 __attribute__((ext_vector_type(8)));
typedef short s16x4 __attribute__((ext_vector_type(4)));
typedef float f32x2 __attribute__((ext_vector_type(2)));
typedef float f32x4 __attribute__((ext_vector_type(4)));
typedef float f32x8 __attribute__((ext_vector_type(8)));
typedef float f32x16 __attribute__((ext_vector_type(16)));
typedef unsigned u32x2 __attribute__((ext_vector_type(2)));
typedef unsigned u32x4 __attribute__((ext_vector_type(4)));

constexpr int DM = 2048, NB = 2, SEQ = 8192, DEPTH = 4, CTX = 256, GRIDW = 64;
constexpr int MLAT = NB * SEQ, MCTX = NB * CTX, MT = MLAT + MCTX;
constexpr int LTOT = CTX + SEQ;
constexpr int NIN = 5712, NP = 5888;
constexpr int DFF = 5632, NUP = 2 * DFF;
constexpr int PC_GQ = 0, PC_GK = 512, PC_GV = 1024, PC_GZ = 1536, PC_DIFF = 2048, PC_MLA = 3584, PC_GAB = 4160, PC_NA = 4352;
constexpr float LN_EPS = 1e-5f, RMS_EPS = 1e-6f;
constexpr float DN_ALPHA = 1.6817928305074290f;

enum { I_X, I_C, I_CTX, I_CCTX, I_WMOD, I_BMOD, I_WIN, I_GCONV, I_GALOG, I_GDT, I_GNORM, I_DLAM, I_DNORM, I_MQN, I_MKVN, I_MWUQ, I_MWUKV, I_RPB, I_WOUT, I_LNG, I_LNB, I_WUP, I_FCONV, I_WDN, N_INPUTS };

constexpr size_t al256(size_t x) { return (x + 255) / 256 * 256; }
constexpr size_t WS_CTL   = 0;
constexpr size_t CTL_BYTES = 65536;
constexpr size_t WS_MODP  = WS_CTL + CTL_BYTES;
constexpr size_t WS_MOD   = WS_MODP + al256((size_t)16 * 4 * 3 * 12288 * 4);
constexpr size_t WS_RTAB  = WS_MOD + al256((size_t)4 * 3 * 12288 * 4);
constexpr size_t WS_WIN   = WS_RTAB + al256(128 * 16 * 8);
constexpr size_t WS_WOUT  = WS_WIN + (size_t)NP * DM * 2;
constexpr size_t WS_WUP   = WS_WOUT + (size_t)DM * DM * 2;
constexpr size_t WS_WDN   = WS_WUP + (size_t)NUP * DM * 2;
constexpr size_t WS_WUQ   = WS_WDN + (size_t)DM * DFF * 2;
constexpr size_t WS_WUKV  = WS_WUQ + (size_t)768 * 384 * 2;
constexpr size_t WS_XBUF  = WS_WUKV + (size_t)1024 * 256 * 2;
constexpr size_t WS_H     = WS_XBUF + (size_t)MT * DM * 4;
constexpr size_t WS_MIX   = WS_H + (size_t)MT * DM * 2;
constexpr size_t WS_G     = WS_MIX + (size_t)MT * DM * 2;
constexpr size_t WS_BIG   = WS_G + (size_t)MT * DFF * 2;
constexpr size_t WB_P     = 0;
constexpr size_t WB_QD    = WB_P + (size_t)MT * NP * 2;
constexpr size_t WB_KD    = WB_QD + (size_t)16 * LTOT * 64 * 2;
constexpr size_t WB_VD    = WB_KD + (size_t)16 * LTOT * 64 * 2;
constexpr size_t WB_OD    = WB_VD + (size_t)8 * LTOT * 128 * 2;
constexpr size_t WB_CQ    = WB_OD + (size_t)2 * MT * 512 * 4;
constexpr size_t WB_CKV   = WB_CQ + (size_t)MT * 384 * 2;
constexpr size_t WB_KROPE = WB_CKV + (size_t)MT * 256 * 2;
constexpr size_t WB_QRAW  = WB_KROPE + (size_t)MT * 64 * 2;
constexpr size_t WB_KVRAW = WB_QRAW + (size_t)MT * 768 * 2;
constexpr size_t WB_QM    = WB_KVRAW + (size_t)MT * 1024 * 2;
constexpr size_t WB_KM    = WB_QM + (size_t)8 * LTOT * 192 * 2;
constexpr size_t WB_VM    = WB_KM + (size_t)8 * LTOT * 192 * 2;
constexpr size_t WB_GQ    = WB_VM + (size_t)8 * LTOT * 128 * 2;
constexpr size_t WB_GATE  = WB_GQ + (size_t)MT * 1536 * 4;
constexpr size_t WB_OG    = WB_GATE + (size_t)MT * 16 * 4;
constexpr size_t WB_END1  = WB_OG + (size_t)2 * MT * 512 * 4;
constexpr size_t WB_Y     = 0;
constexpr size_t WB_U     = 0;
constexpr size_t WB_Y2    = 0;
constexpr size_t WB_END2  = (size_t)MT * NUP * 2;
constexpr size_t WS_END   = WS_BIG + (WB_END1 > WB_END2 ? WB_END1 : WB_END2);

DI unsigned cvtpk(float lo, float hi) { unsigned r; asm volatile("v_cvt_pk_bf16_f32 %0, %1, %2" : "=v"(r) : "v"(lo), "v"(hi)); return r; }
DI float bflo(unsigned w) { return __uint_as_float(w << 16); }
DI float bfhi(unsigned w) { return __uint_as_float(w & 0xffff0000u); }
DI float bf2f(bf16_t v) { return __uint_as_float((unsigned)v << 16); }
DI bf16_t f2bf(float f) { return (bf16_t)(cvtpk(f, 0.f) & 0xffffu); }
template <int M> DI float swz_xor(float v) { return __int_as_float(__builtin_amdgcn_ds_swizzle(__float_as_int(v), 0x1f | (M << 10))); }
DI float wave_sum(float v) { v += swz_xor<1>(v); v += swz_xor<2>(v); v += swz_xor<4>(v); v += swz_xor<8>(v); v += swz_xor<16>(v);
    auto rr = __builtin_amdgcn_permlane32_swap(__float_as_uint(v), __float_as_uint(v), false, false); return __uint_as_float(rr[0]) + __uint_as_float(rr[1]); }
DI float wave_max(float v) { v = fmaxf(v, swz_xor<1>(v)); v = fmaxf(v, swz_xor<2>(v)); v = fmaxf(v, swz_xor<4>(v)); v = fmaxf(v, swz_xor<8>(v)); v = fmaxf(v, swz_xor<16>(v));
    auto rr = __builtin_amdgcn_permlane32_swap(__float_as_uint(v), __float_as_uint(v), false, false); return fmaxf(__uint_as_float(rr[0]), __uint_as_float(rr[1])); }
DI float grp16_sum(float v) { v += swz_xor<1>(v); v += swz_xor<2>(v); v += swz_xor<4>(v); v += swz_xor<8>(v); return v; }
DI float silu_f(float x) { return x / (1.f + __expf(-x)); }
DI float sigmoid_f(float x) { return 1.f / (1.f + __expf(-x)); }
DI float softplus_f(float x) { const float e = __expf(-fabsf(x)); const float l1 = (e < 0.03f) ? e * (1.f - e * (0.5f - e * (0.33333333f - 0.25f * e))) : __logf(1.f + e); return fmaxf(x, 0.f) + l1; }
DI void unpack8(const u32x4 w, float (&f)[8]) { f[0] = bflo(w.x); f[1] = bfhi(w.x); f[2] = bflo(w.y); f[3] = bfhi(w.y); f[4] = bflo(w.z); f[5] = bfhi(w.z); f[6] = bflo(w.w); f[7] = bfhi(w.w); }
DI u32x4 pack8(const float (&f)[8]) { u32x4 w; w.x = cvtpk(f[0], f[1]); w.y = cvtpk(f[2], f[3]); w.z = cvtpk(f[4], f[5]); w.w = cvtpk(f[6], f[7]); return w; }

struct RowInfo { int mr, t, len, b, tok; bool ctx; };
DI RowInfo row_info(int r) { RowInfo i; if (r < MLAT) { i.ctx = false; i.b = r >> 13; i.mr = i.b; i.t = r & (SEQ - 1); i.len = SEQ; i.tok = CTX + i.t; } else { const int q = r - MLAT; i.ctx = true; i.b = q >> 8; i.mr = 2; i.t = q & (CTX - 1); i.len = CTX; i.tok = i.t; } return i; }

#define XB_TMO      128
#define XB_XCNT(j)  (256  + 64 * (j))
#define XB_XSUB(j)  (1280 + 64 * (j))
#define XB_XGEN(j)  (2304 + 64 * (j))
#define XB_TOP      3328
#define XB_TOPGEN   3392
#define XCD_BAR_WORDS 3456
#define XB_SPIN_CAP (1u << 22)
DI unsigned xb_ld(unsigned* p)              { return __hip_atomic_load(p, __ATOMIC_RELAXED, __HIP_MEMORY_SCOPE_AGENT); }
DI unsigned xb_add(unsigned* p, unsigned v) { return __hip_atomic_fetch_add(p, v, __ATOMIC_RELAXED, __HIP_MEMORY_SCOPE_AGENT); }
DI unsigned xb_xcc_id() { return (unsigned)__builtin_amdgcn_s_getreg((3 << 11) | 20) & 0xFu; }
#define XB_SPIN(cond, bar) do { unsigned _sp = 0; while (cond) { __builtin_amdgcn_s_sleep(1); \
    if ((++_sp & 255u) == 0u) { if (xb_ld(&(bar)[XB_TMO])) break; if (_sp > XB_SPIN_CAP) { atomicAdd(&(bar)[XB_TMO], 1u); break; } } } } while (0)
struct XcdBarrier { unsigned* bar; unsigned x; volatile LAS unsigned* st; };
DI XcdBarrier xcd_barrier_post(unsigned* bar, volatile LAS unsigned* st) {
    XcdBarrier b; b.bar = bar; b.x = xb_xcc_id(); b.st = st;
    if (threadIdx.x == 0) (void)xb_add(&bar[XB_XCNT(b.x)], 1u);
    return b;
}
DI void xcd_barrier_complete(unsigned* bar, unsigned x, unsigned& nloc, unsigned& nx) {
    const unsigned G = gridDim.x * gridDim.y * gridDim.z;
    unsigned sum, cnt, mine, sp = 0u;
    for (;;) {
        sum = 0u; cnt = 0u; mine = 0u;
#pragma unroll
        for (unsigned j = 0; j < 16; ++j) { const unsigned c = xb_ld(&bar[XB_XCNT(j)]); sum += c; cnt += (c > 0u) ? 1u : 0u; mine = (j == x) ? c : mine; }
        if (sum == G) break;
        __builtin_amdgcn_s_sleep(1);
        if ((++sp & 255u) == 0u) { if (xb_ld(&bar[XB_TMO])) break; if (sp > XB_SPIN_CAP) { atomicAdd(&bar[XB_TMO], 1u); break; } }
    }
    nloc = mine > 0u ? mine : 1u; nx = cnt > 0u ? cnt : 1u;
}
DI void xcd_barrier(const XcdBarrier& b) {
    asm volatile("s_waitcnt vmcnt(0)" ::: "memory");
    __syncthreads();
    if (threadIdx.x == 0) {
        unsigned* bar = b.bar;
        __builtin_amdgcn_s_waitcnt(0);
        unsigned nloc = b.st[0], nx = b.st[1];
        if (nloc == 0u) { xcd_barrier_complete(bar, b.x, nloc, nx); b.st[0] = nloc; b.st[1] = nx; }
        const unsigned old = xb_add(&bar[XB_XSUB(b.x)], 1u);
        const unsigned gen = old / nloc;
        if (old + 1u == (gen + 1u) * nloc) {
            __builtin_amdgcn_fence(__ATOMIC_RELEASE, "agent");
            asm volatile("s_waitcnt vmcnt(0)" ::: "memory");
            const unsigned og = xb_add(&bar[XB_TOP], 1u);
            const unsigned tg = og / nx;
            if (og + 1u == (tg + 1u) * nx) xb_add(&bar[XB_TOPGEN], 1u);
            else XB_SPIN(xb_ld(&bar[XB_TOPGEN]) == tg, bar);
            __builtin_amdgcn_fence(__ATOMIC_ACQUIRE, "agent");
            xb_add(&bar[XB_XGEN(b.x)], 1u);
            asm volatile("s_waitcnt vmcnt(0)" ::: "memory");
        } else {
            XB_SPIN(xb_ld(&bar[XB_XGEN(b.x)]) == gen, bar);
            __builtin_amdgcn_fence(__ATOMIC_ACQUIRE, "agent");
            asm volatile("s_waitcnt vmcnt(0)" ::: "memory");
        }
    }
    __syncthreads();
}

namespace pg8 {
constexpr int BM = 256, BK = 64, HALF = 128, HTB = HALF * BK * 2, STAGE_BYTES = 8 * HTB, NXCD = 8, WGM = 8;
__host__ __device__ __forceinline__ int lds_byte(int r, int c) { const int st = (r >> 4) * 2 + (c >> 5), rr = r & 15, cc = c & 31, ob = rr * 64 + cc * 2; return st * 1024 + (ob ^ (((ob >> 9) & 1) << 5)); }
__host__ __device__ __forceinline__ void stage_rc(int b, int& R, int& C) { const int st = b / 1024, sb = b % 1024, swz = sb ^ (((sb >> 9) & 1) << 5); R = (st >> 1) * 16 + swz / 64; C = (st & 1) * 32 + (swz % 64) / 2; }
__host__ __device__ __forceinline__ int perm32(int rho) { const int n = rho >> 4, i = rho & 15; return 8 * (i >> 2) + 4 * n + (i & 3); }
struct Unit { int pm, pn; };
struct Gemm { const bf16_t* A; const bf16_t* Bt; int M, N, K; };
struct StaticOrder {
    int nM, nN, nwg, G, c;
    __host__ __device__ void init(int M, int N, int G_, int c_) { nM = M / BM; nN = N / BM; nwg = nM * nN; G = G_; c = c_; }
    __host__ __device__ bool next(int i, Unit& u) const {
        const long L = (long)i * G + c; if (L >= nwg) return false;
        int wgid = (int)L; { const int q = nwg / NXCD, r = nwg % NXCD, xcd = wgid % NXCD, off = wgid / NXCD; wgid = (xcd < r ? xcd * (q + 1) : r * (q + 1) + (xcd - r) * q) + off; }
        const int nig = WGM * nN, gid = wgid / nig, fm = gid * WGM, gsz = (nM - fm) < WGM ? (nM - fm) : WGM;
        u.pm = fm + ((wgid % nig) % gsz); u.pn = (wgid % nig) / gsz; return true;
    }
    __device__ __forceinline__ void a_ready(const Unit&) const {}
    __device__ __forceinline__ void done(const Unit&) const {}
};
struct EpiF32 {
    static constexpr bool PERM = false;
    float* C; int ldc;
    __device__ __forceinline__ void operator()(const f32x4 (&acc)[2][2][4][2], const Unit& u, int wr, int wc, int fr, int fq) const {
        const int row0 = u.pm * BM + wr * 64 + fr, col0 = u.pn * BM + wc * 32 + 4 * fq;
#pragma unroll
        for (int ai = 0; ai < 2; ++ai)
#pragma unroll
            for (int m = 0; m < 4; ++m) { float* rowp = C + (size_t)(row0 + ai * HALF + m * 16) * ldc + col0;
#pragma unroll
                for (int bj = 0; bj < 2; ++bj)
#pragma unroll
                    for (int n = 0; n < 2; ++n) *(f32x4*)(rowp + bj * HALF + n * 16) = acc[ai][bj][m][n]; }
    }
};
struct EpiBf16 {
    static constexpr bool PERM = true;
    bf16_t* O; int ldc;
    __device__ __forceinline__ void operator()(const f32x4 (&acc)[2][2][4][2], const Unit& u, int wr, int wc, int fr, int fq) const {
        const int row0 = u.pm * BM + wr * 64 + fr; const int col0 = u.pn * BM + wc * 32 + 8 * fq;
#pragma unroll
        for (int ai = 0; ai < 2; ++ai)
#pragma unroll
            for (int m = 0; m < 4; ++m) { bf16_t* rowp = O + (size_t)(row0 + ai * HALF + m * 16) * ldc + col0;
#pragma unroll
                for (int bj = 0; bj < 2; ++bj) { const f32x4 v0 = acc[ai][bj][m][0], v1 = acc[ai][bj][m][1];
                    u32x4 w; w.x = cvtpk(v0[0], v0[1]); w.y = cvtpk(v0[2], v0[3]); w.z = cvtpk(v1[0], v1[1]); w.w = cvtpk(v1[2], v1[3]);
                    *(u32x4*)(rowp + bj * HALF) = w; } }
    }
};
template <class Epi, class Sched>
__device__ __forceinline__ void gemm_phase(LAS unsigned char* lds, const Gemm g, const Sched& S, const Epi& E, const int tid) {
    const int wid = __builtin_amdgcn_readfirstlane(tid >> 6), lane = tid & 63, wr = wid >> 2, wc = wid & 3, fr = lane & 15, fq = lane >> 4;
    const int K = g.K, nt = K / BK;
    unsigned voffA[2], voffB[2];
#pragma unroll
    for (int i = 0; i < 2; ++i) { int R, C; stage_rc(tid * 16 + i * 8192, R, C); const int Rb = Epi::PERM ? ((R & ~31) + perm32(R & 31)) : R;
        voffA[i] = (unsigned)(R * K + C) * 2u; voffB[i] = (unsigned)(Rb * K + C) * 2u; }
    const size_t kstep = (size_t)(BK * 2);
    const size_t hstep = (size_t)HALF * K * 2;
    const size_t tstep = 2 * hstep;
    const unsigned ldsw = (unsigned)wid * 1024u;
    const int aoff = lds_byte(wr * 64 + fr, fq * 8), boff = lds_byte(wc * 32 + fr, fq * 8);
#define PG8_SA(b, h) (((b) * 2 + (h)) * HTB)
#define PG8_SB(b, h) ((4 + (b) * 2 + (h)) * HTB)
#define PG8_STAGE(bufoff, gbase, voff) do { _Pragma("unroll") for (int _i = 0; _i < 2; ++_i) \
        __builtin_amdgcn_global_load_lds((const unsigned*)((const char*)(gbase) + (voff)[_i]), (LAS unsigned*)(lds + (bufoff) + ldsw + _i * 8192), 16, 0, 0); } while (0)
#define PG8_LDA(dst, b, h) do { _Pragma("unroll") for (int m = 0; m < 4; ++m) _Pragma("unroll") for (int k = 0; k < 2; ++k) dst[m][k] = *(const LAS bf16x8*)(lds + PG8_SA(b, h) + aoff + m * 2048 + k * 1024); } while (0)
#define PG8_LDB(dst, b, h) do { _Pragma("unroll") for (int n = 0; n < 2; ++n) _Pragma("unroll") for (int k = 0; k < 2; ++k) dst[n][k] = *(const LAS bf16x8*)(lds + PG8_SB(b, h) + boff + n * 2048 + k * 1024); } while (0)
#define PG8_MMA(ai, bj, At, Bt) do { __builtin_amdgcn_s_setprio(1); _Pragma("unroll") for (int m = 0; m < 4; ++m) _Pragma("unroll") for (int n = 0; n < 2; ++n) _Pragma("unroll") for (int k = 0; k < 2; ++k) \
        acc[ai][bj][m][n] = __builtin_amdgcn_mfma_f32_16x16x32_bf16(Bt[n][k], At[m][k], acc[ai][bj][m][n], 0, 0, 0); __builtin_amdgcn_s_setprio(0); } while (0)
#define PG8_WAIT_V(n) asm volatile("s_waitcnt vmcnt(" #n ")" ::: "memory")
#define PG8_WAIT_L(n) asm volatile("s_waitcnt lgkmcnt(" #n ")" ::: "memory")
#define PG8_BAR __builtin_amdgcn_s_barrier()
#define PG8_SCHED __builtin_amdgcn_sched_barrier(0)
    Unit cur, nxt; int ui = 0;
    if (!S.next(0, cur)) return;
    f32x4 acc[2][2][4][2];
#pragma unroll
    for (int a = 0; a < 2; ++a)
#pragma unroll
        for (int b = 0; b < 2; ++b)
#pragma unroll
            for (int m = 0; m < 4; ++m)
#pragma unroll
                for (int n = 0; n < 2; ++n) acc[a][b][m][n] = (f32x4){0.f, 0.f, 0.f, 0.f};
    bf16x8 At[4][2], B0[2][2], B1[2][2];
    const char* cA = (const char*)g.A + (size_t)cur.pm * tstep; const char* cB = (const char*)g.Bt + (size_t)cur.pn * tstep;
    S.a_ready(cur);
    PG8_STAGE(PG8_SB(0, 0), cB, voffB); PG8_STAGE(PG8_SA(0, 0), cA, voffA); PG8_STAGE(PG8_SB(0, 1), cB + hstep, voffB); PG8_STAGE(PG8_SA(0, 1), cA + hstep, voffA);
    if (wr == 1) PG8_BAR;
    PG8_WAIT_V(4); PG8_BAR;
    PG8_STAGE(PG8_SB(1, 0), cB + kstep, voffB); PG8_STAGE(PG8_SA(1, 0), cA + kstep, voffA); PG8_STAGE(PG8_SB(1, 1), cB + hstep + kstep, voffB);
    PG8_WAIT_V(6); PG8_BAR;
    for (;;) {
        const bool has_next = S.next(ui + 1, nxt);
        const char* nA = has_next ? (const char*)g.A + (size_t)nxt.pm * tstep : cA; const char* nB = has_next ? (const char*)g.Bt + (size_t)nxt.pn * tstep : cB;
        for (int t = 0; t < nt; t += 2) {
            const bool last = (t == nt - 2);
            const char* a1 = cA + (size_t)(t + 1) * kstep;
            const char* a2 = last ? nA : cA + (size_t)(t + 2) * kstep; const char* b2 = last ? nB : cB + (size_t)(t + 2) * kstep;
            const char* a3 = a2 + kstep; const char* b3 = b2 + kstep;
            if (last && has_next) S.a_ready(nxt);
            PG8_LDB(B0, 0, 0); PG8_SCHED; PG8_LDA(At, 0, 0); PG8_STAGE(PG8_SA(1, 1), a1 + hstep, voffA);
            PG8_WAIT_L(8); PG8_BAR; PG8_WAIT_L(0); PG8_MMA(0, 0, At, B0); PG8_BAR; PG8_SCHED;
            PG8_LDB(B1, 0, 1); PG8_STAGE(PG8_SB(0, 0), b2, voffB);
            PG8_BAR; PG8_WAIT_L(0); PG8_MMA(0, 1, At, B1); PG8_BAR;
            PG8_LDA(At, 0, 1); PG8_STAGE(PG8_SA(0, 0), a2, voffA);
            PG8_BAR; PG8_WAIT_L(0); PG8_MMA(1, 0, At, B0); PG8_BAR; PG8_SCHED;
            PG8_STAGE(PG8_SB(0, 1), b2 + hstep, voffB);
            PG8_WAIT_V(6); PG8_BAR; PG8_MMA(1, 1, At, B1); PG8_BAR;
            PG8_LDB(B0, 1, 0); PG8_SCHED; PG8_LDA(At, 1, 0); PG8_STAGE(PG8_SA(0, 1), a2 + hstep, voffA);
            PG8_WAIT_L(8); PG8_BAR; PG8_WAIT_L(0); PG8_MMA(0, 0, At, B0); PG8_BAR; PG8_SCHED;
            PG8_LDB(B1, 1, 1); PG8_STAGE(PG8_SB(1, 0), b3, voffB);
            PG8_BAR; PG8_WAIT_L(0); PG8_MMA(0, 1, At, B1); PG8_BAR;
            PG8_LDA(At, 1, 1); PG8_STAGE(PG8_SA(1, 0), a3, voffA);
            PG8_BAR; PG8_WAIT_L(0); PG8_MMA(1, 0, At, B0); PG8_BAR; PG8_SCHED;
            PG8_STAGE(PG8_SB(1, 1), b3 + hstep, voffB);
            PG8_WAIT_V(6); PG8_BAR; PG8_MMA(1, 1, At, B1); PG8_BAR;
        }
        E(acc, cur, wr, wc, fr, fq); S.done(cur);
        if (!has_next) break;
#pragma unroll
        for (int a = 0; a < 2; ++a)
#pragma unroll
            for (int b = 0; b < 2; ++b)
#pragma unroll
                for (int m = 0; m < 4; ++m)
#pragma unroll
                    for (int n = 0; n < 2; ++n) acc[a][b][m][n] = (f32x4){0.f, 0.f, 0.f, 0.f};
        cur = nxt; cA = nA; cB = nB; ++ui;
    }
    PG8_WAIT_V(0);
    if (wr == 0) PG8_BAR;
    PG8_BAR;
#undef PG8_SA
#undef PG8_SB
#undef PG8_STAGE
#undef PG8_LDA
#undef PG8_LDB
#undef PG8_MMA
#undef PG8_WAIT_V
#undef PG8_WAIT_L
#undef PG8_BAR
#undef PG8_SCHED
}
}

namespace att {
constexpr int NW = 8, QBLK = 32, KVBLK = 64, DV = 128;
constexpr float THR = 8.f;
#define SBAR() __builtin_amdgcn_sched_barrier(0)
DI int crow(int r, int hi) { return (r & 3) + 8 * (r >> 2) + 4 * hi; }
template <int DQK> DI int kswz(int row, int colB) { return row * (DQK * 2) + (colB ^ ((row & 7) << 4)); }
DI void partialSM(f32x16& p0, f32x16& p1, float& m_reg, float& mn, float& alpha, const float SCALE) {
  const float C = SCALE * 1.4426950408889634f;
  float pmax = p0[0];
#pragma unroll
  for (int r = 1; r < 16; ++r) pmax = fmaxf(pmax, p0[r]);
#pragma unroll
  for (int r = 0; r < 16; ++r) pmax = fmaxf(pmax, p1[r]);
  { auto rr = __builtin_amdgcn_permlane32_swap(__float_as_uint(pmax), __float_as_uint(pmax), false, false);
    pmax = fmaxf(__uint_as_float(rr[0]), __uint_as_float(rr[1])); }
  if (__builtin_expect(__all(pmax - m_reg <= THR / SCALE), 1)) { mn = m_reg; alpha = 1.f; }
  else { mn = fmaxf(m_reg, pmax); alpha = __builtin_amdgcn_exp2f((m_reg - mn) * C); m_reg = mn; }
  const float mnC = -mn * C;
#pragma unroll
  for (int r = 0; r < 16; ++r) p0[r] = fmaf(p0[r], C, mnC);
#pragma unroll
  for (int r = 0; r < 16; ++r) p1[r] = fmaf(p1[r], C, mnC);
#pragma unroll
  for (int r = 0; r < 16; ++r) p0[r] = __builtin_amdgcn_exp2f(p0[r]);
}
DI void finishSM(f32x16& p0, f32x16& p1, float alpha, float& l_reg, bf16x8& pa0, bf16x8& pa1, bf16x8& pa2, bf16x8& pa3) {
#pragma unroll
  for (int r = 0; r < 16; ++r) p1[r] = __builtin_amdgcn_exp2f(p1[r]);
  float ps = 0;
#pragma unroll
  for (int r = 0; r < 16; ++r) ps += p0[r];
#pragma unroll
  for (int r = 0; r < 16; ++r) ps += p1[r];
  { auto rr = __builtin_amdgcn_permlane32_swap(__float_as_uint(ps), __float_as_uint(ps), false, false);
    ps = __uint_as_float(rr[0]) + __uint_as_float(rr[1]); }
  l_reg = l_reg * alpha + ps;
#define PK4(P, BASE, OUT) do { unsigned a0 = cvtpk(P[BASE + 0], P[BASE + 1]), a1 = cvtpk(P[BASE + 2], P[BASE + 3]);   \
    unsigned b0 = cvtpk(P[BASE + 4], P[BASE + 5]), b1 = cvtpk(P[BASE + 6], P[BASE + 7]);                              \
    auto r0 = __builtin_amdgcn_permlane32_swap(a0, b0, false, false); auto r1 = __builtin_amdgcn_permlane32_swap(a1, b1, false, false); \
    u32x4 w = {r0[0], r1[0], r0[1], r1[1]}; OUT = *reinterpret_cast<bf16x8*>(&w); } while (0)
  PK4(p0, 0, pa0); PK4(p0, 8, pa1); PK4(p1, 0, pa2); PK4(p1, 8, pa3);
#undef PK4
}
template <int DQK> DI void qkt(f32x16& p0, f32x16& p1, const LAS char* Ks, const bf16x8* qr, int r32, int hi) {
  p0 = f32x16{}; p1 = f32x16{};
#pragma unroll
  for (int d0 = 0; d0 < DQK / 16; ++d0) { const int cb = (d0 * 16 + hi * 8) * 2;
    const bf16x8 b0 = *(const LAS bf16x8*)(Ks + kswz<DQK>(r32, cb));
    const bf16x8 b1 = *(const LAS bf16x8*)(Ks + kswz<DQK>(32 + r32, cb));
    p0 = __builtin_amdgcn_mfma_f32_32x32x16_bf16(b0, qr[d0], p0, 0, 0, 0);
    p1 = __builtin_amdgcn_mfma_f32_32x32x16_bf16(b1, qr[d0], p1, 0, 0, 0); }
}
DI int v_st(int k, int c) { const int kk = (k & ~0xC) | ((k & 4) << 1) | ((k & 8) >> 1); return ((kk >> 3) * 4 + (c >> 5)) * 512 + ((kk & 7) * 32 + (c & 31)) * 2; }
DI int v_rd_base(int lane) { return ((lane & 3) << 3) | (((lane >> 2) & 3) << 6) | (((lane >> 4) & 1) << 5) | (((lane >> 5) & 1) << 8); }
constexpr int v_rd_off(int d0, int ks, int half) { return d0 * 512 + ks * 4096 + half * 2048; }
template <int OFF> DI s16x4 tr_read(int vb) { s16x4 r; asm volatile("ds_read_b64_tr_b16 %0, %1 offset:%2" : "=&v"(r) : "v"(vb), "i"(OFF) : "memory"); return r; }
template <int D0> DI void pv_one(f32x16& od, int vb, bf16x8 pa0, bf16x8 pa1, bf16x8 pa2, bf16x8 pa3) {
  const s16x4 l0 = tr_read<v_rd_off(D0, 0, 0)>(vb), h0 = tr_read<v_rd_off(D0, 0, 1)>(vb), l1 = tr_read<v_rd_off(D0, 1, 0)>(vb), h1 = tr_read<v_rd_off(D0, 1, 1)>(vb);
  const s16x4 l2 = tr_read<v_rd_off(D0, 2, 0)>(vb), h2 = tr_read<v_rd_off(D0, 2, 1)>(vb), l3 = tr_read<v_rd_off(D0, 3, 0)>(vb), h3 = tr_read<v_rd_off(D0, 3, 1)>(vb);
  asm volatile("s_waitcnt lgkmcnt(0)" ::: "memory"); SBAR();
#define PK(L, H) (bf16x8){L[0], L[1], L[2], L[3], H[0], H[1], H[2], H[3]}
  od = __builtin_amdgcn_mfma_f32_32x32x16_bf16(pa0, PK(l0, h0), od, 0, 0, 0);
  od = __builtin_amdgcn_mfma_f32_32x32x16_bf16(pa1, PK(l1, h1), od, 0, 0, 0);
  od = __builtin_amdgcn_mfma_f32_32x32x16_bf16(pa2, PK(l2, h2), od, 0, 0, 0);
  od = __builtin_amdgcn_mfma_f32_32x32x16_bf16(pa3, PK(l3, h3), od, 0, 0, 0);
#undef PK
}
DI void pv_d0(f32x16* o, int vb, bf16x8 pa0, bf16x8 pa1, bf16x8 pa2, bf16x8 pa3) {
  pv_one<0>(o[0], vb, pa0, pa1, pa2, pa3); pv_one<1>(o[1], vb, pa0, pa1, pa2, pa3); pv_one<2>(o[2], vb, pa0, pa1, pa2, pa3); pv_one<3>(o[3], vb, pa0, pa1, pa2, pa3);
}
template <int DQK> constexpr int lds_bytes() { return 2 * KVBLK * DV * 2 + 2 * KVBLK * DQK * 2 + NW * 64 * 4; }
template <int DQK, int SDEPTH, bool OUT_BF16>
DI void attn_body(const bf16_t* __restrict__ Qb, const bf16_t* __restrict__ Kh, const bf16_t* __restrict__ Vh, void* __restrict__ Obv, int ldo, int seq, LAS char* lds, const int tid) {
  constexpr int SHM_V = KVBLK * DV * 2, SHM_K = KVBLK * DQK * 2, NKC = DQK / 64, CPR = DQK / 8;
  const float SCALE = (DQK == 64) ? 0.125f : ((DQK == 128) ? 0.088388347648318440f : 0.072168783648703220f);
  const int wid = tid >> 6, lane = tid & 63, r32 = lane & 31, hi = lane >> 5;
  LAS char* V_lds = lds; LAS char* K_lds = lds + 2 * SHM_V;
  LAS float* ws = (LAS float*)(lds + 2 * SHM_V + 2 * SHM_K) + wid * 64; LAS float* li_l = ws; LAS float* al_l = ws + 32;
  float m_reg = -1e30f, l_reg = 0; f32x16 o[4] = {}; bf16x8 qr[DQK / 16];
  const bf16_t* Qw = Qb + (long)(wid * QBLK + r32) * DQK + hi * 8;
#pragma unroll
  for (int d0 = 0; d0 < DQK / 16; ++d0) qr[d0] = *reinterpret_cast<const bf16x8*>(Qw + d0 * 16);
  const int sr = tid >> 4, sc = (tid & 15) * 8, vst0 = v_st(sr, sc), vst1 = v_st(32 + sr, sc);
  int krow[NKC], kcol[NKC];
#pragma unroll
  for (int i = 0; i < NKC; ++i) { const int ci = tid + i * 512; krow[i] = ci / CPR; kcol[i] = (ci % CPR) * 8; }
  const int vb0 = (int)(uintptr_t)V_lds + v_rd_base(lane);
  struct { bf16x8 vs0, vs1, ks[NKC]; } sr_[SDEPTH];
#define SLOAD(i, k0) do { sr_[i].vs0 = *reinterpret_cast<const bf16x8*>(&Vh[(long)((k0) + sr) * DV + sc]); sr_[i].vs1 = *reinterpret_cast<const bf16x8*>(&Vh[(long)((k0) + 32 + sr) * DV + sc]); \
    _Pragma("unroll") for (int _c = 0; _c < NKC; ++_c) sr_[i].ks[_c] = *reinterpret_cast<const bf16x8*>(&Kh[(long)((k0) + krow[_c]) * DQK + kcol[_c]]); } while (0)
#define SWRITE(b, i) do { *(LAS bf16x8*)(V_lds + (b) * SHM_V + vst0) = sr_[i].vs0; *(LAS bf16x8*)(V_lds + (b) * SHM_V + vst1) = sr_[i].vs1; \
    _Pragma("unroll") for (int _c = 0; _c < NKC; ++_c) *(LAS bf16x8*)(K_lds + (b) * SHM_K + kswz<DQK>(krow[_c], kcol[_c] * 2)) = sr_[i].ks[_c]; } while (0)
#define SWAIT() do { if constexpr (SDEPTH == 2) { if constexpr (NKC == 1) asm volatile("s_waitcnt vmcnt(3)" ::: "memory"); else if constexpr (NKC == 2) asm volatile("s_waitcnt vmcnt(4)" ::: "memory"); else asm volatile("s_waitcnt vmcnt(5)" ::: "memory"); } \
    else asm volatile("s_waitcnt vmcnt(0)" ::: "memory"); } while (0)
#define RESC(a) do { if (__any((a) < 1.f)) { if (hi == 0) al_l[r32] = (a); asm volatile("s_waitcnt lgkmcnt(0)" ::: "memory"); \
    _Pragma("unroll") for (int d = 0; d < 4; ++d) _Pragma("unroll") for (int r = 0; r < 16; ++r) o[d][r] *= al_l[crow(r, hi)]; } } while (0)
  f32x16 pA0, pA1, pB0, pB1; float mnA, mnB, alA, alB; bf16x8 pa0, pa1, pa2, pa3; const int NT = seq / KVBLK;
  constexpr int SE = 0, SO = SDEPTH - 1;
  SLOAD(SE, 0); asm volatile("s_waitcnt vmcnt(0)" ::: "memory"); SWRITE(0, SE); __syncthreads();
  qkt<DQK>(pA0, pA1, K_lds, qr, r32, hi); partialSM(pA0, pA1, m_reg, mnA, alA, SCALE);
  SLOAD(SO, KVBLK); if constexpr (SDEPTH == 2) { if (2 < NT) SLOAD(SE, 2 * KVBLK); }
  SWAIT(); SWRITE(1, SO); __syncthreads();
  for (int j = 1; j + 1 < NT; j += 2) {
    SBAR(); qkt<DQK>(pB0, pB1, K_lds + SHM_K, qr, r32, hi);
    finishSM(pA0, pA1, alA, l_reg, pa0, pa1, pa2, pa3); SBAR();
    SLOAD(SO, (j + SDEPTH) * KVBLK); SBAR();
    pv_d0(o, vb0, pa0, pa1, pa2, pa3); partialSM(pB0, pB1, m_reg, mnB, alB, SCALE);
    __syncthreads(); SWAIT(); SWRITE(0, SE);
    RESC(alB); __syncthreads();
    SBAR(); qkt<DQK>(pA0, pA1, K_lds, qr, r32, hi);
    finishSM(pB0, pB1, alB, l_reg, pa0, pa1, pa2, pa3); SBAR();
    if (SDEPTH == 1 || j + 3 < NT) SLOAD(SE, (j + 1 + SDEPTH) * KVBLK); SBAR();
    pv_d0(o, vb0 + SHM_V, pa0, pa1, pa2, pa3); partialSM(pA0, pA1, m_reg, mnA, alA, SCALE);
    __syncthreads(); SWAIT(); SWRITE(1, SO);
    RESC(alA); __syncthreads();
  }
  SBAR(); qkt<DQK>(pB0, pB1, K_lds + SHM_K, qr, r32, hi);
  finishSM(pA0, pA1, alA, l_reg, pa0, pa1, pa2, pa3); SBAR();
  pv_d0(o, vb0, pa0, pa1, pa2, pa3); partialSM(pB0, pB1, m_reg, mnB, alB, SCALE);
  __syncthreads(); RESC(alB);
  finishSM(pB0, pB1, alB, l_reg, pa0, pa1, pa2, pa3); SBAR();
  pv_d0(o, vb0 + SHM_V, pa0, pa1, pa2, pa3);
  if (hi == 0) li_l[r32] = l_reg; asm volatile("s_waitcnt lgkmcnt(0)" ::: "memory");
  float rli[16];
#pragma unroll
  for (int r = 0; r < 16; ++r) rli[r] = __builtin_amdgcn_rcpf(li_l[crow(r, hi)]);
  if constexpr (OUT_BF16) {
    bf16_t* Ow = (bf16_t*)Obv + (long)(wid * QBLK) * ldo;
#pragma unroll
    for (int r = 0; r < 16; ++r) { const int orow = crow(r, hi);
#pragma unroll
      for (int d0 = 0; d0 < 4; ++d0) Ow[(long)orow * ldo + d0 * 32 + r32] = f2bf(o[d0][r] * rli[r]); }
  } else {
    float* Ow = (float*)Obv + (long)(wid * QBLK) * ldo;
#pragma unroll
    for (int r = 0; r < 16; ++r) { const int orow = crow(r, hi);
#pragma unroll
      for (int d0 = 0; d0 < 4; ++d0) Ow[(long)orow * ldo + d0 * 32 + r32] = o[d0][r] * rli[r]; }
  }
  __syncthreads();
#undef SLOAD
#undef SWRITE
#undef SWAIT
#undef RESC
}

template <int DQK, bool OUT_BF16>
DI void attn_body1(const bf16_t* __restrict__ Qb, const bf16_t* __restrict__ Kh, const bf16_t* __restrict__ Vh, void* __restrict__ Obv, int ldo, int seq, LAS char* lds, const int tid) {
  constexpr int SHM_V = KVBLK * DV * 2, SHM_K = KVBLK * DQK * 2, NKC = DQK / 64, CPR = DQK / 8;
  const float SCALE = (DQK == 64) ? 0.125f : ((DQK == 128) ? 0.088388347648318440f : 0.072168783648703220f);
  const int wid = tid >> 6, lane = tid & 63, r32 = lane & 31, hi = lane >> 5;
  LAS char* V_lds = lds; LAS char* K_lds = lds + 2 * SHM_V;
  LAS float* ws = (LAS float*)(lds + 2 * SHM_V + 2 * SHM_K) + wid * 64; LAS float* li_l = ws; LAS float* al_l = ws + 32;
  constexpr int QREG = (DQK / 16 > 8) ? 8 : DQK / 16, QLDS = DQK / 16 - QREG;
  LAS char* Qp = lds + 2 * SHM_V + 2 * SHM_K + NW * 64 * 4 + wid * (QLDS * 1024) + lane * 16;
  float m_reg = -1e30f, l_reg = 0; f32x16 o[4] = {}; bf16x8 qr[QREG];
  const bf16_t* Qw = Qb + (long)(wid * QBLK + r32) * DQK + hi * 8;
#pragma unroll
  for (int d0 = 0; d0 < QREG; ++d0) qr[d0] = *reinterpret_cast<const bf16x8*>(Qw + d0 * 16);
#pragma unroll
  for (int d0 = 0; d0 < QLDS; ++d0) *(LAS bf16x8*)(Qp + d0 * 1024) = *reinterpret_cast<const bf16x8*>(Qw + (QREG + d0) * 16);
  const int sr = tid >> 4, sc = (tid & 15) * 8, vst0 = v_st(sr, sc), vst1 = v_st(32 + sr, sc);
  int krow[NKC], kcol[NKC];
#pragma unroll
  for (int i = 0; i < NKC; ++i) { const int ci = tid + i * 512; krow[i] = ci / CPR; kcol[i] = (ci % CPR) * 8; }
  const int vb0 = (int)(uintptr_t)V_lds + v_rd_base(lane);
  bf16x8 vs0, vs1, ks[NKC];
#define SLOAD1(k0) do { vs0 = *reinterpret_cast<const bf16x8*>(&Vh[(long)((k0) + sr) * DV + sc]); vs1 = *reinterpret_cast<const bf16x8*>(&Vh[(long)((k0) + 32 + sr) * DV + sc]); \
    _Pragma("unroll") for (int _c = 0; _c < NKC; ++_c) ks[_c] = *reinterpret_cast<const bf16x8*>(&Kh[(long)((k0) + krow[_c]) * DQK + kcol[_c]]); } while (0)
#define SWRITE1(b) do { *(LAS bf16x8*)(V_lds + (b) * SHM_V + vst0) = vs0; *(LAS bf16x8*)(V_lds + (b) * SHM_V + vst1) = vs1; \
    _Pragma("unroll") for (int _c = 0; _c < NKC; ++_c) *(LAS bf16x8*)(K_lds + (b) * SHM_K + kswz<DQK>(krow[_c], kcol[_c] * 2)) = ks[_c]; } while (0)
  const int NT = seq / KVBLK;
  SLOAD1(0); asm volatile("s_waitcnt vmcnt(0)" ::: "memory"); SWRITE1(0); __syncthreads();
  for (int j = 0; j < NT; ++j) {
    const int b = j & 1; f32x16 p0, p1; float mn, al; bf16x8 pa0, pa1, pa2, pa3;
    if (j + 1 < NT) SLOAD1((j + 1) * KVBLK);
    SBAR();
    { const LAS char* Ks = K_lds + b * SHM_K; p0 = f32x16{}; p1 = f32x16{};
#pragma unroll
      for (int d0 = 0; d0 < DQK / 16; ++d0) { const int cb = (d0 * 16 + hi * 8) * 2;
        const bf16x8 b0 = *(const LAS bf16x8*)(Ks + kswz<DQK>(r32, cb)); const bf16x8 b1 = *(const LAS bf16x8*)(Ks + kswz<DQK>(32 + r32, cb));
        bf16x8 qf; if (d0 < QREG) qf = qr[d0 < QREG ? d0 : 0]; else qf = *(const LAS bf16x8*)(Qp + (d0 - QREG) * 1024);
        p0 = __builtin_amdgcn_mfma_f32_32x32x16_bf16(b0, qf, p0, 0, 0, 0); p1 = __builtin_amdgcn_mfma_f32_32x32x16_bf16(b1, qf, p1, 0, 0, 0); } }
    partialSM(p0, p1, m_reg, mn, al, SCALE);
    if (__any(al < 1.f)) { if (hi == 0) al_l[r32] = al; asm volatile("s_waitcnt lgkmcnt(0)" ::: "memory");
#pragma unroll
      for (int d = 0; d < 4; ++d)
#pragma unroll
        for (int r = 0; r < 16; ++r) o[d][r] *= al_l[crow(r, hi)]; }
    finishSM(p0, p1, al, l_reg, pa0, pa1, pa2, pa3); SBAR();
    pv_d0(o, vb0 + b * SHM_V, pa0, pa1, pa2, pa3);
    if (j + 1 < NT) { asm volatile("s_waitcnt vmcnt(0)" ::: "memory"); SWRITE1(b ^ 1); }
    __syncthreads();
  }
  if (hi == 0) li_l[r32] = l_reg; asm volatile("s_waitcnt lgkmcnt(0)" ::: "memory");
  float rli[16];
#pragma unroll
  for (int r = 0; r < 16; ++r) rli[r] = __builtin_amdgcn_rcpf(li_l[crow(r, hi)]);
  if constexpr (OUT_BF16) {
    bf16_t* Ow = (bf16_t*)Obv + (long)(wid * QBLK) * ldo;
#pragma unroll
    for (int r = 0; r < 16; ++r) { const int orow = crow(r, hi);
#pragma unroll
      for (int d0 = 0; d0 < 4; ++d0) Ow[(long)orow * ldo + d0 * 32 + r32] = f2bf(o[d0][r] * rli[r]); }
  } else {
    float* Ow = (float*)Obv + (long)(wid * QBLK) * ldo;
#pragma unroll
    for (int r = 0; r < 16; ++r) { const int orow = crow(r, hi);
#pragma unroll
      for (int d0 = 0; d0 < 4; ++d0) Ow[(long)orow * ldo + d0 * 32 + r32] = o[d0][r] * rli[r]; }
  }
  __syncthreads();
#undef SLOAD1
#undef SWRITE1
}
}

constexpr int NWAVES = 8, NTHREADS = 512;
constexpr int LDS_BYTES = 144 * 1024;
struct Args { const float* in[N_INPUTS]; float* out; unsigned char* ws; int pro_lo, pro_hi, l_lo, l_hi, ph_lo, ph_hi, fused, pad; };
struct Frame {
    const float* const* in; float* out; unsigned char* ws; unsigned char* big;
    LAS unsigned char* lds; char* ldsg; int tid, lane, wave, wg, nwg, gw, ngw;
};

DI int win_map(int n) { if (n < 2048) return n; if (n < 4160) return n + 16; if (n < 4176) return n - 2112; if (n < 4352) return -1; return n - 176; }
DI void transpose_item(const float* __restrict__ src, int K, int ld, int Nsrc, bf16_t* __restrict__ dst, int Kp, bool wmap, int k0, int n0, float* tile, int tid) {
    const int nn = tid & 63, kk0 = tid >> 6; const int n = n0 + nn; const int sc = wmap ? win_map(n) : (n < Nsrc ? n : -1);
#pragma unroll
    for (int i = 0; i < 8; ++i) { const int kk = kk0 + 8 * i, k = k0 + kk; tile[kk * 65 + nn] = (k < K && sc >= 0) ? src[(size_t)k * ld + sc] : 0.f; }
    __syncthreads();
    const int wn = tid >> 3, kc = tid & 7; float f[8];
#pragma unroll
    for (int j = 0; j < 8; ++j) f[j] = tile[(kc * 8 + j) * 65 + wn];
    *(u32x4*)(dst + (size_t)(n0 + wn) * Kp + k0 + kc * 8) = pack8(f);
    __syncthreads();
}
DI void convert_layer(const Frame& F, int l) {
    float* tile = (float*)F.ldsg;
    constexpr int I_IN = (DM / 64) * (NP / 64), I_OUT = (DM / 64) * (DM / 64), I_UP = (DM / 64) * (NUP / 64), I_DN = (DFF / 64) * (DM / 64), I_UQ = (384 / 64) * (768 / 64), I_UKV = (256 / 64) * (1024 / 64);
    constexpr int NIT = I_IN + I_OUT + I_UP + I_DN + I_UQ + I_UKV;
    for (int it = F.wg; it < NIT; it += F.nwg) {
        int r = it;
        if (r < I_IN) { transpose_item(F.in[I_WIN] + (size_t)l * DM * NIN, DM, NIN, NIN, (bf16_t*)(F.ws + WS_WIN), DM, true, (r % (DM / 64)) * 64, (r / (DM / 64)) * 64, tile, F.tid); continue; } r -= I_IN;
        if (r < I_OUT) { transpose_item(F.in[I_WOUT] + (size_t)l * DM * DM, DM, DM, DM, (bf16_t*)(F.ws + WS_WOUT), DM, false, (r % (DM / 64)) * 64, (r / (DM / 64)) * 64, tile, F.tid); continue; } r -= I_OUT;
        if (r < I_UP) { transpose_item(F.in[I_WUP] + (size_t)l * DM * NUP, DM, NUP, NUP, (bf16_t*)(F.ws + WS_WUP), DM, false, (r % (DM / 64)) * 64, (r / (DM / 64)) * 64, tile, F.tid); continue; } r -= I_UP;
        if (r < I_DN) { transpose_item(F.in[I_WDN] + (size_t)l * DFF * DM, DFF, DM, DM, (bf16_t*)(F.ws + WS_WDN), DFF, false, (r % (DFF / 64)) * 64, (r / (DFF / 64)) * 64, tile, F.tid); continue; } r -= I_DN;
        if (r < I_UQ) { transpose_item(F.in[I_MWUQ] + (size_t)l * 384 * 768, 384, 768, 768, (bf16_t*)(F.ws + WS_WUQ), 384, false, (r % 6) * 64, (r / 6) * 64, tile, F.tid); continue; } r -= I_UQ;
        transpose_item(F.in[I_MWUKV] + (size_t)l * 128 * 1024, 128, 1024, 1024, (bf16_t*)(F.ws + WS_WUKV), 256, false, (r % 4) * 64, (r / 4) * 64, tile, F.tid);
    }
}

DI void pro_gemv(const Frame& F) {
    float* modp = (float*)(F.ws + WS_MODP);
    const float* c = F.in[I_C]; const float* cc = F.in[I_CCTX];
    for (int it = F.gw; it < 4 * 16 * 48; it += F.ngw) {
        const int l = it / 768, ks = (it / 48) % 16, cg = it % 48; const int n = cg * 256 + F.lane * 4;
        const float* w = F.in[I_WMOD] + (size_t)l * DM * 12288 + n;
        f32x4 a0 = {0, 0, 0, 0}, a1 = a0, a2 = a0;
        for (int k = ks * 128; k < ks * 128 + 128; ++k) {
            const f32x4 wv = *(const f32x4*)(w + (size_t)k * 12288);
            const float s0 = silu_f(c[k]), s1 = silu_f(c[DM + k]), s2 = silu_f(cc[k]);
            a0 += wv * s0; a1 += wv * s1; a2 += wv * s2;
        }
        float* o = modp + ((size_t)(ks * 4 + l) * 3) * 12288 + n;
        *(f32x4*)(o) = a0; *(f32x4*)(o + 12288) = a1; *(f32x4*)(o + 2 * 12288) = a2;
    }
    f32x2* rt = (f32x2*)(F.ws + WS_RTAB);
    for (int i = F.wg * NTHREADS + F.tid; i < 128 * 16; i += F.nwg * NTHREADS) {
        const int pos = i >> 4, fi = i & 15; const float inv = exp2f(-(float)fi * (13.287712379549449f / 16.f)); const float ang = (float)pos * inv;
        rt[i] = (f32x2){cosf(ang), sinf(ang)};
    }
}
DI void pro_modreduce(const Frame& F) {
    const float* modp = (const float*)(F.ws + WS_MODP); float* mod = (float*)(F.ws + WS_MOD);
    for (int i = F.wg * NTHREADS + F.tid; i < 4 * 3 * 12288; i += F.nwg * NTHREADS) {
        const int l = i / (3 * 12288), n = i % 12288;
        float s = F.in[I_BMOD][l * 12288 + n];
        for (int ks = 0; ks < 16; ++ks) s += modp[(size_t)ks * 4 * 3 * 12288 + i];
        mod[i] = s;
    }
}
DI const float* x_row_in(const Frame& F, int r) { return r < MLAT ? F.in[I_X] + (size_t)r * DM : F.in[I_CTX] + (size_t)(r - MLAT) * DM; }
DI const float* modv(const Frame& F, int l, int mr, int j) { return (const float*)(F.ws + WS_MOD) + ((size_t)(l * 3 + mr) * 6 + j) * DM; }
DI void pro_h0(const Frame& F) {
    bf16_t* h = (bf16_t*)(F.ws + WS_H);
    for (int r = F.gw; r < MT; r += F.ngw) {
        const RowInfo ri = row_info(r); const float* x = x_row_in(F, r); const float* m0 = modv(F, 0, ri.mr, 0); const float* m1 = modv(F, 0, ri.mr, 1);
#pragma unroll
        for (int i = 0; i < 4; ++i) { const int c = (i * 64 + F.lane) * 8; float f[8];
            const f32x4 a = *(const f32x4*)(x + c), b = *(const f32x4*)(x + c + 4), s0 = *(const f32x4*)(m1 + c), s1 = *(const f32x4*)(m1 + c + 4), t0 = *(const f32x4*)(m0 + c), t1 = *(const f32x4*)(m0 + c + 4);
#pragma unroll
            for (int j = 0; j < 4; ++j) { f[j] = a[j] * (1.f + s0[j]) + t0[j]; f[4 + j] = b[j] * (1.f + s1[j]) + t1[j]; }
            *(u32x4*)(h + (size_t)r * DM + c) = pack8(f); }
    }
}

DI void rope_pair(float& a, float& b, const f32x2 cs) { const float x1 = a, x2 = b; a = x1 * cs.x - x2 * cs.y; b = x1 * cs.y + x2 * cs.x; }
DI void prep_rows(const Frame& F, int l) {
    const bf16_t* p = (const bf16_t*)(F.big + WB_P);
    float* gq = (float*)(F.big + WB_GQ); float* gate = (float*)(F.big + WB_GATE);
    bf16_t* Qd = (bf16_t*)(F.big + WB_QD); bf16_t* Kd = (bf16_t*)(F.big + WB_KD); bf16_t* Vd = (bf16_t*)(F.big + WB_VD);
    bf16_t* cq = (bf16_t*)(F.big + WB_CQ); bf16_t* ckv = (bf16_t*)(F.big + WB_CKV); bf16_t* krope = (bf16_t*)(F.big + WB_KROPE);
    const f32x2* rt = (const f32x2*)(F.ws + WS_RTAB);
    const float* gconv = F.in[I_GCONV] + (size_t)l * 3 * 1536;
    const int lane = F.lane;
    for (int r = F.gw; r < MT; r += F.ngw) {
        const RowInfo ri = row_info(r); const bf16_t* pr = p + (size_t)r * NP;
        const bool hasm = ri.t > 0, hasn = ri.t < ri.len - 1;
#pragma unroll
        for (int i = 0; i < 3; ++i) {
            const int c0 = (i * 64 + lane) * 8; float xc[8], xm[8], xn[8], y[8];
            unpack8(*(const u32x4*)(pr + c0), xc);
            if (hasm) unpack8(*(const u32x4*)(pr - NP + c0), xm); else { for (int j = 0; j < 8; ++j) xm[j] = 0.f; }
            if (hasn) unpack8(*(const u32x4*)(pr + NP + c0), xn); else { for (int j = 0; j < 8; ++j) xn[j] = 0.f; }
            float ss = 0.f;
#pragma unroll
            for (int j = 0; j < 8; ++j) { const float v = gconv[c0 + j] * xm[j] + gconv[1536 + c0 + j] * xc[j] + gconv[2 * 1536 + c0 + j] * xn[j]; y[j] = silu_f(v); ss += y[j] * y[j]; }
            if (i < 2) { ss = grp16_sum(ss); const float sc = rsqrtf(ss + RMS_EPS) * (i == 0 ? 0.08838834764831845f : 1.f);
#pragma unroll
                for (int j = 0; j < 8; ++j) y[j] *= sc; }
            *(f32x4*)(gq + (size_t)r * 1536 + c0) = (f32x4){y[0], y[1], y[2], y[3]}; *(f32x4*)(gq + (size_t)r * 1536 + c0 + 4) = (f32x4){y[4], y[5], y[6], y[7]};
        }
        if (lane < 16) {
            const float x = bf2f(pr[PC_GAB + lane]); const int dh = lane & 7; float g;
            if (lane < 8) g = -__expf(F.in[I_GALOG][l * 8 + dh]) * softplus_f(x + F.in[I_GDT][l * 8 + dh]); else g = sigmoid_f(x);
            gate[(size_t)r * 16 + lane] = g;
        }
        const int prow = ri.t >> 6, pcol = ri.t & 63;
        {
            const int hs = lane >> 3, e = lane & 7, h = hs >> 1, sub = hs & 1; const int hd = (ri.b * 4 + h) * 2 + sub;
#pragma unroll
            for (int qk = 0; qk < 2; ++qk) {
                const bf16_t* s = pr + PC_DIFF + qk * 512 + h * 128 + sub * 64 + 2 * e;
                const unsigned w0 = *(const unsigned*)(s), w1 = *(const unsigned*)(s + 16), w2 = *(const unsigned*)(s + 32), w3 = *(const unsigned*)(s + 48);
                float a0 = bflo(w0), a1 = bfhi(w0), b0 = bflo(w1), b1 = bfhi(w1), c0 = bflo(w2), c1 = bfhi(w2), d0 = bflo(w3), d1 = bfhi(w3);
                if (!ri.ctx) { rope_pair(a0, b0, rt[prow * 16 + 2 * e]); rope_pair(a1, b1, rt[prow * 16 + 2 * e + 1]); rope_pair(c0, d0, rt[pcol * 16 + 2 * e]); rope_pair(c1, d1, rt[pcol * 16 + 2 * e + 1]); }
                bf16_t* d = (qk == 0 ? Qd : Kd) + ((size_t)hd * LTOT + ri.tok) * 64 + 2 * e;
                *(unsigned*)(d) = cvtpk(a0, a1); *(unsigned*)(d + 16) = cvtpk(b0, b1); *(unsigned*)(d + 32) = cvtpk(c0, c1); *(unsigned*)(d + 48) = cvtpk(d0, d1);
            }
            const int hv = lane >> 4, dv0 = (lane & 15) * 8;
            *(u32x4*)(Vd + ((size_t)(ri.b * 4 + hv) * LTOT + ri.tok) * 128 + dv0) = *(const u32x4*)(pr + PC_DIFF + 1024 + hv * 128 + dv0);
        }
        {
            float v[6]; float ss = 0.f;
#pragma unroll
            for (int i = 0; i < 3; ++i) { const unsigned w = *(const unsigned*)(pr + PC_MLA + 2 * (lane + 64 * i)); v[2 * i] = bflo(w); v[2 * i + 1] = bfhi(w); ss += v[2 * i] * v[2 * i] + v[2 * i + 1] * v[2 * i + 1]; }
            ss = wave_sum(ss); const float rs = rsqrtf(ss * (1.f / 384.f) + RMS_EPS); const float* g = F.in[I_MQN] + l * 384;
#pragma unroll
            for (int i = 0; i < 3; ++i) { const int c = 2 * (lane + 64 * i); *(unsigned*)(cq + (size_t)r * 384 + c) = cvtpk(v[2 * i] * rs * g[c], v[2 * i + 1] * rs * g[c + 1]); }
            const unsigned w = *(const unsigned*)(pr + PC_MLA + 384 + 2 * lane); const float k0 = bflo(w), k1 = bfhi(w);
            float s2 = wave_sum(k0 * k0 + k1 * k1); const float rs2 = rsqrtf(s2 * (1.f / 128.f) + RMS_EPS); const float* g2 = F.in[I_MKVN] + l * 128;
            *(unsigned*)(ckv + (size_t)r * 256 + 2 * lane) = cvtpk(k0 * rs2 * g2[2 * lane], k1 * rs2 * g2[2 * lane + 1]);
            *(unsigned*)(ckv + (size_t)r * 256 + 128 + 2 * lane) = 0u;
            if (lane < 16) {
                const bf16_t* s = pr + PC_MLA + 512; float a = bf2f(s[lane]), b = bf2f(s[16 + lane]), c = bf2f(s[32 + lane]), d = bf2f(s[48 + lane]);
                if (!ri.ctx) { rope_pair(a, b, rt[prow * 16 + lane]); rope_pair(c, d, rt[pcol * 16 + lane]); }
                bf16_t* o = krope + (size_t)r * 64; o[lane] = f2bf(a); o[16 + lane] = f2bf(b); o[32 + lane] = f2bf(c); o[48 + lane] = f2bf(d);
            }
        }
    }
}
DI void mla_assemble(const Frame& F) {
    const bf16_t* qraw = (const bf16_t*)(F.big + WB_QRAW); const bf16_t* kvraw = (const bf16_t*)(F.big + WB_KVRAW); const bf16_t* krope = (const bf16_t*)(F.big + WB_KROPE);
    bf16_t* Qm = (bf16_t*)(F.big + WB_QM); bf16_t* Km = (bf16_t*)(F.big + WB_KM); bf16_t* Vm = (bf16_t*)(F.big + WB_VM);
    const f32x2* rt = (const f32x2*)(F.ws + WS_RTAB); const int lane = F.lane;
    for (int r = F.gw; r < MT; r += F.ngw) {
        const RowInfo ri = row_info(r); const int prow = ri.t >> 6, pcol = ri.t & 63;
        const bf16_t kr = krope[(size_t)r * 64 + lane];
#pragma unroll
        for (int h = 0; h < 4; ++h) {
            const size_t o = (size_t)(ri.b * 4 + h) * LTOT + ri.tok;
            const bf16_t* q = qraw + (size_t)r * 768 + h * 192; const bf16_t* kv = kvraw + (size_t)r * 1024 + h * 256;
            *(unsigned*)(Qm + o * 192 + 2 * lane) = *(const unsigned*)(q + 2 * lane);
            if (lane < 16) { float a = bf2f(q[128 + lane]), b = bf2f(q[144 + lane]), c = bf2f(q[160 + lane]), d = bf2f(q[176 + lane]);
                if (!ri.ctx) { rope_pair(a, b, rt[prow * 16 + lane]); rope_pair(c, d, rt[pcol * 16 + lane]); }
                bf16_t* qo = Qm + o * 192 + 128; qo[lane] = f2bf(a); qo[16 + lane] = f2bf(b); qo[32 + lane] = f2bf(c); qo[48 + lane] = f2bf(d); }
            *(unsigned*)(Km + o * 192 + 2 * lane) = *(const unsigned*)(kv + 2 * lane);
            Km[o * 192 + 128 + lane] = kr;
            *(unsigned*)(Vm + o * 128 + 2 * lane) = *(const unsigned*)(kv + 128 + 2 * lane);
        }
    }
}
DI void attn_diff_phase(const Frame& F) {
    const bf16_t* Qd = (const bf16_t*)(F.big + WB_QD); const bf16_t* Kd = (const bf16_t*)(F.big + WB_KD); const bf16_t* Vd = (const bf16_t*)(F.big + WB_VD); float* Od = (float*)(F.big + WB_OD);
    for (int u = F.wg; u < 16 * 33; u += F.nwg) {
        const int hd = u / 33, qb = u % 33;
        const int bh = hd >> 1, sub = hd & 1, b = bh >> 2, h = bh & 3;
        const bool ctx = qb == 32; const int tok0 = ctx ? 0 : CTX + qb * 256; const int row0 = ctx ? MLAT + b * CTX : b * SEQ + qb * 256;
        att::attn_body<64, 2, false>(Qd + ((size_t)hd * LTOT + tok0) * 64, Kd + (size_t)hd * LTOT * 64, Vd + (size_t)bh * LTOT * 128,
                                     Od + ((size_t)sub * MT + row0) * 512 + h * 128, 512, ctx ? CTX : LTOT, (LAS char*)F.lds, F.tid);
    }
}
DI void attn_mla_phase(const Frame& F) {
    const bf16_t* Qm = (const bf16_t*)(F.big + WB_QM); const bf16_t* Km = (const bf16_t*)(F.big + WB_KM); const bf16_t* Vm = (const bf16_t*)(F.big + WB_VM); bf16_t* mix = (bf16_t*)(F.ws + WS_MIX);
    for (int u = F.wg; u < 8 * 33; u += F.nwg) {
        const int bh = u / 33, qb = u % 33, b = bh >> 2, h = bh & 3;
        const bool ctx = qb == 32; const int tok0 = ctx ? 0 : CTX + qb * 256; const int row0 = ctx ? MLAT + b * CTX : b * SEQ + qb * 256;
        att::attn_body1<192, true>(Qm + ((size_t)bh * LTOT + tok0) * 192, Km + (size_t)bh * LTOT * 192, Vm + (size_t)bh * LTOT * 128,
                                     mix + (size_t)row0 * DM + 1024 + h * 128, DM, ctx ? CTX : LTOT, (LAS char*)F.lds, F.tid);
    }
}
DI void na_naive(const Frame& F, int l) {
    const bf16_t* p = (const bf16_t*)(F.big + WB_P); bf16_t* mix = (bf16_t*)(F.ws + WS_MIX);
    float* qs = (float*)F.ldsg + F.wave * 512;
    float* ps = qs + 128;
    const int lane = F.lane; const float scale = 0.08838834764831845f;
    const float* rpb = F.in[I_RPB] + (size_t)l * 4 * 15 * 31;
    for (int it = F.gw; it < MT * 4; it += F.ngw) {
        const int r = it >> 2, h = it & 3; const RowInfo ri = row_info(r);
        const bf16_t* q = p + (size_t)r * NP + PC_NA + h * 128;
        { const unsigned w = *(const unsigned*)(q + 2 * lane); qs[2 * lane] = bflo(w); qs[2 * lane + 1] = bfhi(w); }
        asm volatile("s_waitcnt lgkmcnt(0)" ::: "memory");
        const int gr = ri.t >> 6, gc = ri.t & 63;
        const int rs = min(max(gr - 4, 0), 120), cs = min(max(gc - 8, 0), 48);
        const int nkeys = ri.ctx ? 256 : 384; const int nper = nkeys / 64;
#pragma unroll 1
        for (int i = 0; i < nper; ++i) {
            const int idx = lane + 64 * i; int krow; float bias = 0.f;
            if (!ri.ctx && idx < 128) { const int rr = rs + (idx >> 4), ck = cs + (idx & 15); krow = ri.b * SEQ + rr * 64 + ck; bias = rpb[(h * 15 + (rr - gr + 7)) * 31 + (ck - gc + 15)]; }
            else { krow = MLAT + ri.b * CTX + (ri.ctx ? idx : idx - 128); }
            const bf16_t* k = p + (size_t)krow * NP + PC_NA + 512 + h * 128; float d = 0.f;
#pragma unroll 4
            for (int c8 = 0; c8 < 16; ++c8) { float kf[8]; unpack8(*(const u32x4*)(k + c8 * 8), kf); const f32x4 q0 = *(const f32x4*)(qs + c8 * 8), q1 = *(const f32x4*)(qs + c8 * 8 + 4);
                d += kf[0] * q0[0] + kf[1] * q0[1] + kf[2] * q0[2] + kf[3] * q0[3] + kf[4] * q1[0] + kf[5] * q1[1] + kf[6] * q1[2] + kf[7] * q1[3]; }
            ps[idx] = d * scale + bias;
        }
        asm volatile("s_waitcnt lgkmcnt(0)" ::: "memory");
        float sc[6]; float mx = -1e30f;
#pragma unroll
        for (int i = 0; i < 6; ++i) { sc[i] = (i < nper) ? ps[lane + 64 * i] : -1e30f; mx = fmaxf(mx, sc[i]); }
        mx = wave_max(mx); float sum = 0.f;
#pragma unroll
        for (int i = 0; i < 6; ++i) { sc[i] = (i < nper) ? __expf(sc[i] - mx) : 0.f; sum += sc[i]; }
        sum = wave_sum(sum); const float inv = 1.f / sum;
#pragma unroll
        for (int i = 0; i < 6; ++i) if (i < nper) ps[lane + 64 * i] = sc[i] * inv;
        asm volatile("s_waitcnt lgkmcnt(0)" ::: "memory");
        float o0 = 0.f, o1 = 0.f;
#pragma unroll 4
        for (int idx = 0; idx < nkeys; ++idx) {
            int krow;
            if (!ri.ctx && idx < 128) krow = ri.b * SEQ + (rs + (idx >> 4)) * 64 + cs + (idx & 15); else krow = MLAT + ri.b * CTX + (ri.ctx ? idx : idx - 128);
            const unsigned w = *(const unsigned*)(p + (size_t)krow * NP + PC_NA + 1024 + h * 128 + 2 * lane); const float pr = ps[idx];
            o0 += pr * bflo(w); o1 += pr * bfhi(w);
        }
        *(unsigned*)(mix + (size_t)r * DM + 1536 + h * 128 + 2 * lane) = cvtpk(o0, o1);
        asm volatile("s_waitcnt lgkmcnt(0)" ::: "memory");
    }
}
DI void gdn_naive(const Frame& F) {
    if (F.wave != 0 || F.wg >= 32) return;
    const float* gq = (const float*)(F.big + WB_GQ); const float* gate = (const float*)(F.big + WB_GATE); float* og = (float*)(F.big + WB_OG);
    const int chain = F.wg >> 1, dvh = F.wg & 1, dir = chain >> 3, b = (chain >> 2) & 1, h = chain & 3; const int dv = dvh * 64 + F.lane;
    LAS float* kq = (LAS float*)F.lds;
    float S[128];
#pragma unroll
    for (int i = 0; i < 128; ++i) S[i] = 0.f;
    for (int seg = 0; seg < 2; ++seg) {
        const int n = seg == 0 ? CTX : SEQ; const int base = seg == 0 ? MLAT + b * CTX : b * SEQ;
#pragma unroll 1
        for (int i = 0; i < n; ++i) {
            const int r = base + (dir ? n - 1 - i : i);
            const float* row = gq + (size_t)r * 1536;
            kq[F.lane] = row[512 + h * 128 + F.lane]; kq[64 + F.lane] = row[512 + h * 128 + 64 + F.lane];
            kq[128 + F.lane] = row[h * 128 + F.lane]; kq[192 + F.lane] = row[h * 128 + 64 + F.lane];
            const float a = __expf(gate[(size_t)r * 16 + dir * 4 + h]), beta = gate[(size_t)r * 16 + 8 + dir * 4 + h];
            const float v = row[1024 + h * 128 + dv];
            asm volatile("s_waitcnt lgkmcnt(0)" ::: "memory");
            float ks = 0.f;
#pragma unroll
            for (int c = 0; c < 8; ++c) {
#pragma unroll
                for (int j4 = 0; j4 < 4; ++j4) { const f32x4 kv = *(const LAS f32x4*)(kq + c * 16 + j4 * 4);
#pragma unroll
                    for (int e = 0; e < 4; ++e) ks += kv[e] * S[c * 16 + j4 * 4 + e]; }
                asm volatile("" ::: "memory");
            }
            const float coef = beta * (v - a * ks);
            float o = 0.f;
#pragma unroll
            for (int c = 0; c < 8; ++c) {
#pragma unroll
                for (int j4 = 0; j4 < 4; ++j4) { const f32x4 kv = *(const LAS f32x4*)(kq + c * 16 + j4 * 4), qv = *(const LAS f32x4*)(kq + 128 + c * 16 + j4 * 4);
#pragma unroll
                    for (int e = 0; e < 4; ++e) { const int j = c * 16 + j4 * 4 + e; S[j] = a * S[j] + coef * kv[e]; o += qv[e] * S[j]; } }
                asm volatile("" ::: "memory");
            }
            og[((size_t)dir * MT + r) * 512 + h * 128 + dv] = o;
        }
    }
}
DI void mixer_post(const Frame& F, int l) {
    const bf16_t* p = (const bf16_t*)(F.big + WB_P); const float* og = (const float*)(F.big + WB_OG); const float* Od = (const float*)(F.big + WB_OD); bf16_t* mix = (bf16_t*)(F.ws + WS_MIX);
    const int lane = F.lane; const int c0 = lane * 8, d0 = (lane & 15) * 8;
    const float lam_init = 0.8f - 0.6f * __expf(-0.3f * (float)l);
    float lam; { const float* lf = F.in[I_DLAM] + l * 256; float s1 = wave_sum(lf[lane] * lf[64 + lane]), s2 = wave_sum(lf[128 + lane] * lf[192 + lane]); lam = expf(s1) - expf(s2) + lam_init; }
    const float* gn = F.in[I_GNORM] + l * 128 + d0; const float* dn = F.in[I_DNORM] + l * 128 + d0;
    for (int r = F.gw; r < MT; r += F.ngw) {
        {
            const float* a = og + (size_t)r * 512 + c0; const float* bq = og + ((size_t)MT + r) * 512 + c0; float o[8], z[8]; float ss = 0.f;
            const f32x4 a0 = *(const f32x4*)a, a1 = *(const f32x4*)(a + 4), b0 = *(const f32x4*)bq, b1 = *(const f32x4*)(bq + 4);
#pragma unroll
            for (int j = 0; j < 4; ++j) { o[j] = a0[j] + b0[j]; o[4 + j] = a1[j] + b1[j]; }
#pragma unroll
            for (int j = 0; j < 8; ++j) ss += o[j] * o[j];
            ss = grp16_sum(ss); const float rs = rsqrtf(ss * (1.f / 128.f) + RMS_EPS);
            unpack8(*(const u32x4*)(p + (size_t)r * NP + PC_GZ + c0), z);
#pragma unroll
            for (int j = 0; j < 8; ++j) o[j] = o[j] * rs * gn[j] * silu_f(z[j]);
            *(u32x4*)(mix + (size_t)r * DM + c0) = pack8(o);
        }
        {
            const float* a = Od + (size_t)r * 512 + c0; const float* bq = Od + ((size_t)MT + r) * 512 + c0; float o[8]; float ss = 0.f;
            const f32x4 a0 = *(const f32x4*)a, a1 = *(const f32x4*)(a + 4), b0 = *(const f32x4*)bq, b1 = *(const f32x4*)(bq + 4);
#pragma unroll
            for (int j = 0; j < 4; ++j) { o[j] = a0[j] - lam * b0[j]; o[4 + j] = a1[j] - lam * b1[j]; }
#pragma unroll
            for (int j = 0; j < 8; ++j) ss += o[j] * o[j];
            ss = grp16_sum(ss); const float rs = rsqrtf(ss * (1.f / 128.f) + RMS_EPS) * (1.f - lam_init);
#pragma unroll
            for (int j = 0; j < 8; ++j) o[j] = o[j] * rs * dn[j];
            *(u32x4*)(mix + (size_t)r * DM + 512 + c0) = pack8(o);
        }
    }
}
DI void ln_phase(const Frame& F, int l, int which) {
    const float* y = (const float*)(F.big + WB_Y); float* xbuf = (float*)(F.ws + WS_XBUF); bf16_t* hb = (bf16_t*)(F.ws + WS_H);
    const float* lg = F.in[I_LNG] + (size_t)(l * 2 + which) * DM; const float* lb = F.in[I_LNB] + (size_t)(l * 2 + which) * DM;
    const bool first = (l == 0 && which == 0), lastl = (l == DEPTH - 1 && which == 1);
    const int lane = F.lane;
    for (int r = F.gw; r < MT; r += F.ngw) {
        const RowInfo ri = row_info(r);
        const float* x = first ? x_row_in(F, r) : xbuf + (size_t)r * DM; const float* yr = y + (size_t)r * DM;
        const float* mA = modv(F, l, ri.mr, which == 0 ? 2 : 5);
        float z[32]; float s = 0.f;
#pragma unroll
        for (int i = 0; i < 8; ++i) { const int c = (i * 64 + lane) * 4; const f32x4 xv = *(const f32x4*)(x + c), yv = *(const f32x4*)(yr + c), mv = *(const f32x4*)(mA + c);
#pragma unroll
            for (int j = 0; j < 4; ++j) { z[i * 4 + j] = DN_ALPHA * xv[j] + mv[j] * yv[j]; s += z[i * 4 + j]; } }
        s = wave_sum(s); const float mu = s * (1.f / DM); float q = 0.f;
#pragma unroll
        for (int i = 0; i < 32; ++i) { const float d = z[i] - mu; q += d * d; }
        q = wave_sum(q); const float rstd = rsqrtf(q * (1.f / DM) + LN_EPS);
        const float* mS = nullptr; const float* mT = nullptr;
        if (which == 0) { mT = modv(F, l, ri.mr, 3); mS = modv(F, l, ri.mr, 4); } else if (!lastl) { mT = modv(F, l + 1, ri.mr, 0); mS = modv(F, l + 1, ri.mr, 1); }
        float* xo = (lastl && r < MLAT) ? F.out + (size_t)r * DM : xbuf + (size_t)r * DM;
#pragma unroll
        for (int i = 0; i < 8; ++i) { const int c = (i * 64 + lane) * 4; const f32x4 gv = *(const f32x4*)(lg + c), bv = *(const f32x4*)(lb + c); f32x4 xn;
#pragma unroll
            for (int j = 0; j < 4; ++j) xn[j] = (z[i * 4 + j] - mu) * rstd * gv[j] + bv[j];
            *(f32x4*)(xo + c) = xn;
            if (mS) { const f32x4 sv = *(const f32x4*)(mS + c), tv = *(const f32x4*)(mT + c);
                u32x2 w; w.x = cvtpk(xn[0] * (1.f + sv[0]) + tv[0], xn[1] * (1.f + sv[1]) + tv[1]); w.y = cvtpk(xn[2] * (1.f + sv[2]) + tv[2], xn[3] * (1.f + sv[3]) + tv[3]);
                *(u32x2*)(hb + (size_t)r * DM + c) = w; } }
    }
}
DI void ffn_convact(const Frame& F, int l) {
    const bf16_t* u = (const bf16_t*)(F.big + WB_U); bf16_t* g = (bf16_t*)(F.ws + WS_G);
    const float* cw = F.in[I_FCONV] + (size_t)l * 3 * NUP;
    constexpr int CPRW = DFF / 8;
    for (size_t it = (size_t)F.wg * NTHREADS + F.tid; it < (size_t)MT * CPRW; it += (size_t)F.nwg * NTHREADS) {
        const int r = (int)(it / CPRW), c0 = (int)(it % CPRW) * 8; const RowInfo ri = row_info(r);
        const bool hasm = ri.t > 0, hasn = ri.t < ri.len - 1; const bf16_t* ur = u + (size_t)r * NUP;
        float o[8];
        float gc[8], gm[8], gn[8], vc[8], vm[8], vn[8];
        unpack8(*(const u32x4*)(ur + c0), gc); unpack8(*(const u32x4*)(ur + DFF + c0), vc);
        if (hasm) { unpack8(*(const u32x4*)(ur - NUP + c0), gm); unpack8(*(const u32x4*)(ur - NUP + DFF + c0), vm); } else { for (int j = 0; j < 8; ++j) { gm[j] = 0.f; vm[j] = 0.f; } }
        if (hasn) { unpack8(*(const u32x4*)(ur + NUP + c0), gn); unpack8(*(const u32x4*)(ur + NUP + DFF + c0), vn); } else { for (int j = 0; j < 8; ++j) { gn[j] = 0.f; vn[j] = 0.f; } }
#pragma unroll
        for (int j = 0; j < 8; ++j) {
            const float ga = cw[c0 + j] * gm[j] + cw[NUP + c0 + j] * gc[j] + cw[2 * NUP + c0 + j] * gn[j];
            const float va = cw[DFF + c0 + j] * vm[j] + cw[NUP + DFF + c0 + j] * vc[j] + cw[2 * NUP + DFF + c0 + j] * vn[j];
            o[j] = silu_f(ga) * va; }
        *(u32x4*)(g + (size_t)r * DFF + c0) = pack8(o);
    }
}

constexpr int NPRO = 3, NPH = 15;
__global__ void __launch_bounds__(NTHREADS, 2) fwd(Args a) {
    extern __shared__ __attribute__((aligned(16))) unsigned char lds_raw[];
#define FR() Frame F; { unsigned z_ = 0u; asm volatile("; launder zero" : "+v"(z_)); int w0_ = wave0; asm volatile("; launder wave" : "+s"(w0_)); int t_ = w0_ * 64 + (int)__builtin_amdgcn_mbcnt_hi(~0u, __builtin_amdgcn_mbcnt_lo(~0u, z_)); int w_ = blockIdx.x; asm volatile("; launder wg" : "+s"(w_)); unsigned char* ws_ = a.ws; asm volatile("; launder ws" : "+s"(ws_)); \
    F.in = a.in; F.out = a.out; F.ws = ws_; F.big = ws_ + WS_BIG; \
    F.lds = (LAS unsigned char*)lds_raw; F.ldsg = (char*)lds_raw; F.tid = t_; F.lane = t_ & 63; F.wave = __builtin_amdgcn_readfirstlane(t_ >> 6); F.wg = w_; F.nwg = gridDim.x; F.gw = F.wg * NWAVES + F.wave; F.ngw = F.nwg * NWAVES; }
    LAS unsigned char* lds0 = (LAS unsigned char*)lds_raw;
    const int wave0 = __builtin_amdgcn_readfirstlane(threadIdx.x >> 6);
    volatile LAS unsigned* xbw = (volatile LAS unsigned*)(lds0 + LDS_BYTES - 16);
    if (threadIdx.x == 0) { xbw[0] = 0u; xbw[1] = 0u; xbw[2] = 0u; xbw[3] = 0u; }
    __syncthreads();
    XcdBarrier bar; bar.bar = (unsigned*)(a.ws + WS_CTL); bar.x = 0; bar.st = xbw;
    if (a.fused) bar = xcd_barrier_post((unsigned*)(a.ws + WS_CTL), xbw);
#define SEAM() do { if (a.fused) xcd_barrier(bar); } while (0)
#ifndef ONLY
#define ONLY -1
#endif
#define PIN(k) ((ONLY < 0 || ONLY == 100 + (k)) && a.pro_lo <= (k) && (k) < a.pro_hi)
#define IN(k) ((ONLY < 0 || ONLY == (k)) && a.ph_lo <= (k) && (k) < a.ph_hi)
    if (PIN(0)) { { FR(); convert_layer(F, 0); pro_gemv(F); } SEAM(); }
    if (PIN(1)) { { FR(); pro_modreduce(F); } SEAM(); }
    if (PIN(2)) { { FR(); pro_h0(F); } SEAM(); }
    for (int l = a.l_lo; l < a.l_hi; ++l) {
        if (IN(0)) {
            FR();
            pg8::Gemm g{(const bf16_t*)(F.ws + WS_H), (const bf16_t*)(F.ws + WS_WIN), MT, NP, DM}; pg8::StaticOrder S; S.init(MT, NP, F.nwg, F.wg);
            pg8::EpiBf16 E{(bf16_t*)(F.big + WB_P), NP}; pg8::gemm_phase(F.lds, g, S, E, F.tid); SEAM(); }
        if (IN(1)) { { FR(); prep_rows(F, l); } SEAM(); }
        if (IN(2)) {
            FR();
#pragma unroll 1
            for (int s2 = 0; s2 < 2; ++s2) {
                const bf16_t* Ap = (const bf16_t*)(F.big + (s2 ? WB_CKV : WB_CQ)); const bf16_t* Bp = (const bf16_t*)(F.ws + (s2 ? WS_WUKV : WS_WUQ));
                const int Ng = s2 ? 1024 : 768, Kg = s2 ? 256 : 384;
                pg8::Gemm g{Ap, Bp, MT, Ng, Kg}; pg8::StaticOrder S; S.init(MT, Ng, F.nwg, F.wg);
                pg8::EpiBf16 E{(bf16_t*)(F.big + (s2 ? WB_KVRAW : WB_QRAW)), Ng}; pg8::gemm_phase(F.lds, g, S, E, F.tid);
            }
            SEAM(); }
        if (IN(3)) { { FR(); mla_assemble(F); } SEAM(); }
        if (IN(4)) { { FR(); attn_diff_phase(F); } SEAM(); }
        if (IN(5)) { { FR(); attn_mla_phase(F); } SEAM(); }
        if (IN(6)) { { FR(); na_naive(F, l); } SEAM(); }
        if (IN(7)) { { FR(); gdn_naive(F); } SEAM(); }
        if (IN(8)) { { FR(); mixer_post(F, l); } SEAM(); }
        if (IN(9)) {
            FR();
            pg8::Gemm g{(const bf16_t*)(F.ws + WS_MIX), (const bf16_t*)(F.ws + WS_WOUT), MT, DM, DM}; pg8::StaticOrder S; S.init(MT, DM, F.nwg, F.wg);
            pg8::EpiF32 E{(float*)(F.big + WB_Y), DM}; pg8::gemm_phase(F.lds, g, S, E, F.tid); SEAM(); }
        if (IN(10)) { { FR(); ln_phase(F, l, 0); } SEAM(); }
        if (IN(11)) {
            FR();
            pg8::Gemm g{(const bf16_t*)(F.ws + WS_H), (const bf16_t*)(F.ws + WS_WUP), MT, NUP, DM}; pg8::StaticOrder S; S.init(MT, NUP, F.nwg, F.wg);
            pg8::EpiBf16 E{(bf16_t*)(F.big + WB_U), NUP}; pg8::gemm_phase(F.lds, g, S, E, F.tid); SEAM(); }
        if (IN(12)) { { FR(); ffn_convact(F, l); } SEAM(); }
        if (IN(13)) {
            FR();
            pg8::Gemm g{(const bf16_t*)(F.ws + WS_G), (const bf16_t*)(F.ws + WS_WDN), MT, DM, DFF}; pg8::StaticOrder S; S.init(MT, DM, F.nwg, F.wg);
            pg8::EpiF32 E{(float*)(F.big + WB_Y2), DM}; pg8::gemm_phase(F.lds, g, S, E, F.tid); SEAM(); }
        if (IN(14)) { { FR(); ln_phase(F, l, 1); if (l + 1 < DEPTH) convert_layer(F, l + 1); } if (l + 1 < a.l_hi) SEAM(); }
    }
#undef SEAM
#undef PIN
#undef IN
}

extern "C" void kernel_launch(void* const* d_in, const int* in_sizes, int n_in, void* d_out, int out_size, void* d_ws, size_t ws_size, hipStream_t stream) {
    static int grid = 0;
    if (grid == 0) {
        if (n_in != N_INPUTS || out_size != MLAT * DM || ws_size < WS_END) { fprintf(stderr, "kernel_launch: unexpected shapes: n_in %d out %d ws %zu (need %zu)\n", n_in, out_size, ws_size, (size_t)WS_END); grid = -1; return; }
        int dev = 0, cus = 0, per_cu = 0;
        if (hipGetDevice(&dev) != hipSuccess || hipDeviceGetAttribute(&cus, hipDeviceAttributeMultiprocessorCount, dev) != hipSuccess) { grid = -1; return; }
        if (hipFuncSetAttribute((const void*)fwd, hipFuncAttributeMaxDynamicSharedMemorySize, LDS_BYTES) != hipSuccess) { fprintf(stderr, "kernel_launch: hipFuncSetAttribute failed\n"); grid = -1; return; }
        if (hipOccupancyMaxActiveBlocksPerMultiprocessor(&per_cu, (const void*)fwd, NTHREADS, LDS_BYTES) != hipSuccess || per_cu < 1) { fprintf(stderr, "kernel_launch: occupancy query says %d\n", per_cu); }
        (void)hipGetLastError();
        grid = cus;
    }
    if (grid < 0) return;
    (void)hipMemsetAsync((char*)d_ws + WS_CTL, 0, CTL_BYTES, stream);
    Args a{};
    for (int i = 0; i < N_INPUTS; ++i) a.in[i] = (const float*)d_in[i];
    a.out = (float*)d_out; a.ws = (unsigned char*)d_ws; a.pad = 0;
#if MK_FUSED
    a.pro_lo = 0; a.pro_hi = NPRO; a.l_lo = 0; a.l_hi = DEPTH; a.ph_lo = 0; a.ph_hi = NPH; a.fused = 1;
    hipLaunchKernelGGL(fwd, dim3(grid), dim3(NTHREADS), LDS_BYTES, stream, a);
#else
    a.fused = 0;
    for (int k = 0; k < NPRO; ++k) { a.pro_lo = k; a.pro_hi = k + 1; a.l_lo = 0; a.l_hi = 0; a.ph_lo = 0; a.ph_hi = 0; hipLaunchKernelGGL(fwd, dim3(grid), dim3(NTHREADS), LDS_BYTES, stream, a); }
    a.pro_lo = 0; a.pro_hi = 0;
    for (int l = 0; l < DEPTH; ++l) for (int k = 0; k < NPH; ++k) { a.l_lo = l; a.l_hi = l + 1; a.ph_lo = k; a.ph_hi = k + 1; hipLaunchKernelGGL(fwd, dim3(grid), dim3(NTHREADS), LDS_BYTES, stream, a); }
#endif
    const hipError_t le = hipPeekAtLastError();
    if (le != hipSuccess) fprintf(stderr, "kernel_launch: launch failed: %s\n", hipGetErrorName(le));
}
```

```cpp
#include <hip/hip_runtime.h>
#include <cstdio>
#include <cstdint>

#ifndef REP_PHASE
#define REP_PHASE -1
#define REP_COUNT 1
#endif
#ifndef MK_FUSED
#define MK_FUSED 1
#endif

#define DI __device__ __forceinline__
#define LAS __attribute__((address_space(3)))
typedef unsigned short bf16_t;
typedef short bf16x8 __attribute__((ext_vector_type(8)));
typedef short s16x4 __attribute__((ext_vector_type(4)));
typedef float f32x2 __attribute__((ext_vector_type(2)));
typedef float f32x4 __attribute__((ext_vector_type(4)));
typedef float f32x8 __attribute__((ext_vector_type(8)));
typedef float f32x16 __attribute__((ext_vector_type(16)));
typedef unsigned u32x2 __attribute__((ext_vector_type(2)));
typedef unsigned u32x4 __attribute__((ext_vector_type(4)));

constexpr int DM = 2048, NB = 2, SEQ = 8192, DEPTH = 4, CTX = 256, GRIDW = 64;
constexpr int MLAT = NB * SEQ, MCTX = NB * CTX, MT = MLAT + MCTX;
constexpr int LTOT = CTX + SEQ;
constexpr int NIN = 5712, NP = 5888;
constexpr int DFF = 5632, NUP = 2 * DFF;
constexpr int PC_GQ = 0, PC_GK = 512, PC_GV = 1024, PC_GZ = 1536, PC_DIFF = 2048, PC_MLA = 3584, PC_GAB = 4160, PC_NA = 4352;
constexpr float LN_EPS = 1e-5f, RMS_EPS = 1e-6f;
constexpr float DN_ALPHA = 1.6817928305074290f;

enum { I_X, I_C, I_CTX, I_CCTX, I_WMOD, I_BMOD, I_WIN, I_GCONV, I_GALOG, I_GDT, I_GNORM, I_DLAM, I_DNORM, I_MQN, I_MKVN, I_MWUQ, I_MWUKV, I_RPB, I_WOUT, I_LNG, I_LNB, I_WUP, I_FCONV, I_WDN, N_INPUTS };

constexpr size_t al256(size_t x) { return (x + 255) / 256 * 256; }
constexpr size_t WS_CTL   = 0;
constexpr size_t CTL_BYTES = 65536;
constexpr size_t WS_MODP  = WS_CTL + CTL_BYTES;
constexpr size_t WS_MOD   = WS_MODP + al256((size_t)16 * 4 * 3 * 12288 * 4);
constexpr size_t WS_RTAB  = WS_MOD + al256((size_t)4 * 3 * 12288 * 4);
constexpr size_t WS_WIN   = WS_RTAB + al256(128 * 16 * 8);
constexpr size_t WS_WOUT  = WS_WIN + (size_t)NP * DM * 2;
constexpr size_t WS_WUP   = WS_WOUT + (size_t)DM * DM * 2;
constexpr size_t WS_WDN   = WS_WUP + (size_t)NUP * DM * 2;
constexpr size_t WS_WUQ   = WS_WDN + (size_t)DM * DFF * 2;
constexpr size_t WS_WUKV  = WS_WUQ + (size_t)768 * 384 * 2;
constexpr size_t WS_XBUF  = WS_WUKV + (size_t)1024 * 256 * 2;
constexpr size_t WS_H     = WS_XBUF + (size_t)MT * DM * 4;
constexpr size_t WS_MIX   = WS_H + (size_t)MT * DM * 2;
constexpr size_t WS_G     = WS_MIX + (size_t)MT * DM * 2;
constexpr size_t WS_BIG   = WS_G + (size_t)MT * DFF * 2;
constexpr size_t WB_P     = 0;
constexpr size_t WB_QD    = WB_P + (size_t)MT * NP * 2;
constexpr size_t WB_KD    = WB_QD + (size_t)16 * LTOT * 64 * 2;
constexpr size_t WB_VD    = WB_KD + (size_t)16 * LTOT * 64 * 2;
constexpr size_t WB_OD    = WB_VD + (size_t)8 * LTOT * 128 * 2;
constexpr size_t WB_CQ    = WB_OD + (size_t)2 * MT * 512 * 4;
constexpr size_t WB_CKV   = WB_CQ + (size_t)MT * 384 * 2;
constexpr size_t WB_KROPE = WB_CKV + (size_t)MT * 256 * 2;
constexpr size_t WB_QRAW  = WB_KROPE + (size_t)MT * 64 * 2;
constexpr size_t WB_KVRAW = WB_QRAW + (size_t)MT * 768 * 2;
constexpr size_t WB_QM    = WB_KVRAW + (size_t)MT * 1024 * 2;
constexpr size_t WB_KM    = WB_QM + (size_t)8 * LTOT * 192 * 2;
constexpr size_t WB_VM    = WB_KM + (size_t)8 * LTOT * 192 * 2;
constexpr size_t WB_GATE  = WB_VM + (size_t)8 * LTOT * 128 * 2;
constexpr size_t WB_OG    = WB_GATE + (size_t)MT * 16 * 4;
constexpr size_t WB_GQB   = WB_OG + (size_t)2 * MT * 512 * 4;
constexpr size_t WB_END1  = WB_GQB + (size_t)MT * 1536 * 2;
constexpr int GDN_NCH = 132, GDN_NITEM = 2 * 8 * GDN_NCH;
constexpr size_t WG_WF    = WS_G;
constexpr size_t WG_KF    = WG_WF + (size_t)GDN_NITEM * 16384;
constexpr size_t WG_UF    = WG_KF + (size_t)GDN_NITEM * 16384;
constexpr size_t WG_VF    = WG_UF + (size_t)GDN_NITEM * 32768;
constexpr size_t WG_EGL   = WG_VF + (size_t)GDN_NITEM * 16384;
constexpr size_t WG_GTAB  = WG_EGL + al256((size_t)GDN_NITEM * 4);
constexpr size_t WG_END   = WG_GTAB + (size_t)GDN_NITEM * 256;
static_assert(WG_END <= WS_BIG, "GDN operands must fit in the G region");
constexpr size_t WH_SF    = WS_H;
static_assert((size_t)GDN_NITEM * 32768 <= (size_t)MT * DM * 2, "state fragments must fit in the H region");
constexpr size_t WB_Y     = 0;
constexpr size_t WB_U     = 0;
constexpr size_t WB_Y2    = 0;
constexpr size_t WB_END2  = (size_t)MT * NUP * 2;
constexpr size_t WS_END   = WS_BIG + (WB_END1 > WB_END2 ? WB_END1 : WB_END2);

typedef __bf16 bf16x2n __attribute__((ext_vector_type(2)));
DI unsigned cvtpk(float lo, float hi) { const f32x2 v = {lo, hi}; const bf16x2n r = __builtin_convertvector(v, bf16x2n); return __builtin_bit_cast(unsigned, r); }
DI float bflo(unsigned w) { return __uint_as_float(w << 16); }
DI float bfhi(unsigned w) { return __uint_as_float(w & 0xffff0000u); }
DI float bf2f(bf16_t v) { return __uint_as_float((unsigned)v << 16); }
DI bf16_t f2bf(float f) { return (bf16_t)(cvtpk(f, 0.f) & 0xffffu); }
template <int M> DI float swz_xor(float v) { return __int_as_float(__builtin_amdgcn_ds_swizzle(__float_as_int(v), 0x1f | (M << 10))); }
DI float wave_sum(float v) { v += swz_xor<1>(v); v += swz_xor<2>(v); v += swz_xor<4>(v); v += swz_xor<8>(v); v += swz_xor<16>(v);
    auto rr = __builtin_amdgcn_permlane32_swap(__float_as_uint(v), __float_as_uint(v), false, false); return __uint_as_float(rr[0]) + __uint_as_float(rr[1]); }
DI float wave_max(float v) { v = fmaxf(v, swz_xor<1>(v)); v = fmaxf(v, swz_xor<2>(v)); v = fmaxf(v, swz_xor<4>(v)); v = fmaxf(v, swz_xor<8>(v)); v = fmaxf(v, swz_xor<16>(v));
    auto rr = __builtin_amdgcn_permlane32_swap(__float_as_uint(v), __float_as_uint(v), false, false); return fmaxf(__uint_as_float(rr[0]), __uint_as_float(rr[1])); }
DI float grp16_sum(float v) { v += swz_xor<1>(v); v += swz_xor<2>(v); v += swz_xor<4>(v); v += swz_xor<8>(v); return v; }
DI float silu_f(float x) { return x / (1.f + __expf(-x)); }
DI float sigmoid_f(float x) { return 1.f / (1.f + __expf(-x)); }
DI float softplus_f(float x) { const float e = __expf(-fabsf(x)); const float l1 = (e < 0.03f) ? e * (1.f - e * (0.5f - e * (0.33333333f - 0.25f * e))) : __logf(1.f + e); return fmaxf(x, 0.f) + l1; }
DI void unpack8(const u32x4 w, float (&f)[8]) { f[0] = bflo(w.x); f[1] = bfhi(w.x); f[2] = bflo(w.y); f[3] = bfhi(w.y); f[4] = bflo(w.z); f[5] = bfhi(w.z); f[6] = bflo(w.w); f[7] = bfhi(w.w); }
DI u32x4 pack8(const float (&f)[8]) { u32x4 w; w.x = cvtpk(f[0], f[1]); w.y = cvtpk(f[2], f[3]); w.z = cvtpk(f[4], f[5]); w.w = cvtpk(f[6], f[7]); return w; }

struct RowInfo { int mr, t, len, b, tok; bool ctx; };
DI RowInfo row_info(int r) { RowInfo i; if (r < MLAT) { i.ctx = false; i.b = r >> 13; i.mr = i.b; i.t = r & (SEQ - 1); i.len = SEQ; i.tok = CTX + i.t; } else { const int q = r - MLAT; i.ctx = true; i.b = q >> 8; i.mr = 2; i.t = q & (CTX - 1); i.len = CTX; i.tok = i.t; } return i; }

#define XB_TMO      128
#define XB_XCNT(j)  (256  + 64 * (j))
#define XB_XSUB(j)  (1280 + 64 * (j))
#define XB_XGEN(j)  (2304 + 64 * (j))
#define XB_TOP      3328
#define XB_TOPGEN   3392
#define XCD_BAR_WORDS 3456
#define XB_SPIN_CAP (1u << 22)
DI unsigned xb_ld(unsigned* p)              { return __hip_atomic_load(p, __ATOMIC_RELAXED, __HIP_MEMORY_SCOPE_AGENT); }
DI unsigned xb_add(unsigned* p, unsigned v) { return __hip_atomic_fetch_add(p, v, __ATOMIC_RELAXED, __HIP_MEMORY_SCOPE_AGENT); }
DI unsigned xb_xcc_id() { return (unsigned)__builtin_amdgcn_s_getreg((3 << 11) | 20) & 0xFu; }
#define XB_SPIN(cond, bar) do { unsigned _sp = 0; while (cond) { __builtin_amdgcn_s_sleep(1); \
    if ((++_sp & 255u) == 0u) { if (xb_ld(&(bar)[XB_TMO])) break; if (_sp > XB_SPIN_CAP) { atomicAdd(&(bar)[XB_TMO], 1u); break; } } } } while (0)
struct XcdBarrier { unsigned* bar; unsigned x; volatile LAS unsigned* st; };
DI XcdBarrier xcd_barrier_post(unsigned* bar, volatile LAS unsigned* st) {
    XcdBarrier b; b.bar = bar; b.x = xb_xcc_id(); b.st = st;
    if (threadIdx.x == 0) (void)xb_add(&bar[XB_XCNT(b.x)], 1u);
    return b;
}
DI void xcd_barrier_complete(unsigned* bar, unsigned x, unsigned& nloc, unsigned& nx) {
    const unsigned G = gridDim.x * gridDim.y * gridDim.z;
    unsigned sum, cnt, mine, sp = 0u;
    for (;;) {
        sum = 0u; cnt = 0u; mine = 0u;
#pragma unroll
        for (unsigned j = 0; j < 16; ++j) { const unsigned c = xb_ld(&bar[XB_XCNT(j)]); sum += c; cnt += (c > 0u) ? 1u : 0u; mine = (j == x) ? c : mine; }
        if (sum == G) break;
        __builtin_amdgcn_s_sleep(1);
        if ((++sp & 255u) == 0u) { if (xb_ld(&bar[XB_TMO])) break; if (sp > XB_SPIN_CAP) { atomicAdd(&bar[XB_TMO], 1u); break; } }
    }
    nloc = mine > 0u ? mine : 1u; nx = cnt > 0u ? cnt : 1u;
}
DI void xcd_barrier(const XcdBarrier& b) {
    asm volatile("s_waitcnt vmcnt(0)" ::: "memory");
    __syncthreads();
    if (threadIdx.x == 0) {
        unsigned* bar = b.bar;
        __builtin_amdgcn_s_waitcnt(0);
        unsigned nloc = b.st[0], nx = b.st[1];
        if (nloc == 0u) { xcd_barrier_complete(bar, b.x, nloc, nx); b.st[0] = nloc; b.st[1] = nx; }
        const unsigned old = xb_add(&bar[XB_XSUB(b.x)], 1u);
        const unsigned gen = old / nloc;
        if (old + 1u == (gen + 1u) * nloc) {
            __builtin_amdgcn_fence(__ATOMIC_RELEASE, "agent");
            asm volatile("s_waitcnt vmcnt(0)" ::: "memory");
            const unsigned og = xb_add(&bar[XB_TOP], 1u);
            const unsigned tg = og / nx;
            if (og + 1u == (tg + 1u) * nx) xb_add(&bar[XB_TOPGEN], 1u);
            else XB_SPIN(xb_ld(&bar[XB_TOPGEN]) == tg, bar);
            __builtin_amdgcn_fence(__ATOMIC_ACQUIRE, "agent");
            xb_add(&bar[XB_XGEN(b.x)], 1u);
            asm volatile("s_waitcnt vmcnt(0)" ::: "memory");
        } else {
            XB_SPIN(xb_ld(&bar[XB_XGEN(b.x)]) == gen, bar);
            __builtin_amdgcn_fence(__ATOMIC_ACQUIRE, "agent");
            asm volatile("s_waitcnt vmcnt(0)" ::: "memory");
        }
    }
    __syncthreads();
}

namespace pg8 {
constexpr int BM = 256, BK = 64, HALF = 128, HTB = HALF * BK * 2, STAGE_BYTES = 8 * HTB, NXCD = 8, WGM = 8;
__host__ __device__ __forceinline__ int lds_byte(int r, int c) { const int st = (r >> 4) * 2 + (c >> 5), rr = r & 15, cc = c & 31, ob = rr * 64 + cc * 2; return st * 1024 + (ob ^ (((ob >> 9) & 1) << 5)); }
__host__ __device__ __forceinline__ void stage_rc(int b, int& R, int& C) { const int st = b / 1024, sb = b % 1024, swz = sb ^ (((sb >> 9) & 1) << 5); R = (st >> 1) * 16 + swz / 64; C = (st & 1) * 32 + (swz % 64) / 2; }
__host__ __device__ __forceinline__ int perm32(int rho) { const int n = rho >> 4, i = rho & 15; return 8 * (i >> 2) + 4 * n + (i & 3); }
struct Unit { int pm, pn; };
struct Gemm { const bf16_t* A; const bf16_t* Bt; int M, N, K; };
struct StaticOrder {
    int nM, nN, nwg, G, c;
    __host__ __device__ void init(int M, int N, int G_, int c_) { nM = M / BM; nN = N / BM; nwg = nM * nN; G = G_; c = c_; }
    __host__ __device__ bool next(int i, Unit& u) const {
        const long L = (long)i * G + c; if (L >= nwg) return false;
        int wgid = (int)L; { const int q = nwg / NXCD, r = nwg % NXCD, xcd = wgid % NXCD, off = wgid / NXCD; wgid = (xcd < r ? xcd * (q + 1) : r * (q + 1) + (xcd - r) * q) + off; }
        const int nig = WGM * nN, gid = wgid / nig, fm = gid * WGM, gsz = (nM - fm) < WGM ? (nM - fm) : WGM;
        u.pm = fm + ((wgid % nig) % gsz); u.pn = (wgid % nig) / gsz; return true;
    }
    __device__ __forceinline__ void a_ready(const Unit&) const {}
    __device__ __forceinline__ void done(const Unit&) const {}
};
struct EpiF32 {
    static constexpr bool PERM = false;
    float* C; int ldc;
    __device__ __forceinline__ void operator()(const f32x4 (&acc)[2][2][4][2], const Unit& u, int wr, int wc, int fr, int fq) const {
        const int row0 = u.pm * BM + wr * 64 + fr, col0 = u.pn * BM + wc * 32 + 4 * fq;
#pragma unroll
        for (int ai = 0; ai < 2; ++ai)
#pragma unroll
            for (int m = 0; m < 4; ++m) { float* rowp = C + (size_t)(row0 + ai * HALF + m * 16) * ldc + col0;
#pragma unroll
                for (int bj = 0; bj < 2; ++bj)
#pragma unroll
                    for (int n = 0; n < 2; ++n) *(f32x4*)(rowp + bj * HALF + n * 16) = acc[ai][bj][m][n]; }
    }
};
struct EpiBf16 {
    static constexpr bool PERM = true;
    bf16_t* O; int ldc;
    __device__ __forceinline__ void operator()(const f32x4 (&acc)[2][2][4][2], const Unit& u, int wr, int wc, int fr, int fq) const {
        const int row0 = u.pm * BM + wr * 64 + fr; const int col0 = u.pn * BM + wc * 32 + 8 * fq;
#pragma unroll
        for (int ai = 0; ai < 2; ++ai)
#pragma unroll
            for (int m = 0; m < 4; ++m) { bf16_t* rowp = O + (size_t)(row0 + ai * HALF + m * 16) * ldc + col0;
#pragma unroll
                for (int bj = 0; bj < 2; ++bj) { const f32x4 v0 = acc[ai][bj][m][0], v1 = acc[ai][bj][m][1];
                    u32x4 w; w.x = cvtpk(v0[0], v0[1]); w.y = cvtpk(v0[2], v0[3]); w.z = cvtpk(v1[0], v1[1]); w.w = cvtpk(v1[2], v1[3]);
                    *(u32x4*)(rowp + bj * HALF) = w; } }
    }
};
template <class Epi, class Sched>
__device__ __forceinline__ void gemm_phase(LAS unsigned char* lds, const Gemm g, const Sched& S, const Epi& E, const int tid) {
    const int wid = __builtin_amdgcn_readfirstlane(tid >> 6), lane = tid & 63, wr = wid >> 2, wc = wid & 3, fr = lane & 15, fq = lane >> 4;
    const int K = g.K, nt = K / BK;
    unsigned voffA[2], voffB[2];
#pragma unroll
    for (int i = 0; i < 2; ++i) { int R, C; stage_rc(tid * 16 + i * 8192, R, C); const int Rb = Epi::PERM ? ((R & ~31) + perm32(R & 31)) : R;
        voffA[i] = (unsigned)(R * K + C) * 2u; voffB[i] = (unsigned)(Rb * K + C) * 2u; }
    const size_t kstep = (size_t)(BK * 2);
    const size_t hstep = (size_t)HALF * K * 2;
    const size_t tstep = 2 * hstep;
    const unsigned ldsw = (unsigned)wid * 1024u;
    const int aoff = lds_byte(wr * 64 + fr, fq * 8), boff = lds_byte(wc * 32 + fr, fq * 8);
#define PG8_SA(b, h) (((b) * 2 + (h)) * HTB)
#define PG8_SB(b, h) ((4 + (b) * 2 + (h)) * HTB)
#define PG8_STAGE(bufoff, gbase, voff) do { _Pragma("unroll") for (int _i = 0; _i < 2; ++_i) \
        __builtin_amdgcn_global_load_lds((const unsigned*)((const char*)(gbase) + (voff)[_i]), (LAS unsigned*)(lds + (bufoff) + ldsw + _i * 8192), 16, 0, 0); } while (0)
#define PG8_LDA(dst, b, h) do { _Pragma("unroll") for (int m = 0; m < 4; ++m) _Pragma("unroll") for (int k = 0; k < 2; ++k) dst[m][k] = *(const LAS bf16x8*)(lds + PG8_SA(b, h) + aoff + m * 2048 + k * 1024); } while (0)
#define PG8_LDB(dst, b, h) do { _Pragma("unroll") for (int n = 0; n < 2; ++n) _Pragma("unroll") for (int k = 0; k < 2; ++k) dst[n][k] = *(const LAS bf16x8*)(lds + PG8_SB(b, h) + boff + n * 2048 + k * 1024); } while (0)
#define PG8_MMA(ai, bj, At, Bt) do { __builtin_amdgcn_s_setprio(1); _Pragma("unroll") for (int m = 0; m < 4; ++m) _Pragma("unroll") for (int n = 0; n < 2; ++n) _Pragma("unroll") for (int k = 0; k < 2; ++k) \
        acc[ai][bj][m][n] = __builtin_amdgcn_mfma_f32_16x16x32_bf16(Bt[n][k], At[m][k], acc[ai][bj][m][n], 0, 0, 0); __builtin_amdgcn_s_setprio(0); } while (0)
#define PG8_WAIT_V(n) asm volatile("s_waitcnt vmcnt(" #n ")" ::: "memory")
#define PG8_WAIT_L(n) asm volatile("s_waitcnt lgkmcnt(" #n ")" ::: "memory")
#define PG8_BAR __builtin_amdgcn_s_barrier()
#define PG8_SCHED __builtin_amdgcn_sched_barrier(0)
    Unit cur, nxt; int ui = 0;
    if (!S.next(0, cur)) return;
    f32x4 acc[2][2][4][2];
#pragma unroll
    for (int a = 0; a < 2; ++a)
#pragma unroll
        for (int b = 0; b < 2; ++b)
#pragma unroll
            for (int m = 0; m < 4; ++m)
#pragma unroll
                for (int n = 0; n < 2; ++n) acc[a][b][m][n] = (f32x4){0.f, 0.f, 0.f, 0.f};
    bf16x8 At[4][2], B0[2][2], B1[2][2];
    const char* cA = (const char*)g.A + (size_t)cur.pm * tstep; const char* cB = (const char*)g.Bt + (size_t)cur.pn * tstep;
    S.a_ready(cur);
    PG8_STAGE(PG8_SB(0, 0), cB, voffB); PG8_STAGE(PG8_SA(0, 0), cA, voffA); PG8_STAGE(PG8_SB(0, 1), cB + hstep, voffB); PG8_STAGE(PG8_SA(0, 1), cA + hstep, voffA);
    if (wr == 1) PG8_BAR;
    PG8_WAIT_V(4); PG8_BAR;
    PG8_STAGE(PG8_SB(1, 0), cB + kstep, voffB); PG8_STAGE(PG8_SA(1, 0), cA + kstep, voffA); PG8_STAGE(PG8_SB(1, 1), cB + hstep + kstep, voffB);
    PG8_WAIT_V(6); PG8_BAR;
    for (;;) {
        const bool has_next = S.next(ui + 1, nxt);
        const char* nA = has_next ? (const char*)g.A + (size_t)nxt.pm * tstep : cA; const char* nB = has_next ? (const char*)g.Bt + (size_t)nxt.pn * tstep : cB;
        for (int t = 0; t < nt; t += 2) {
            const bool last = (t == nt - 2);
            const char* a1 = cA + (size_t)(t + 1) * kstep;
            const char* a2 = last ? nA : cA + (size_t)(t + 2) * kstep; const char* b2 = last ? nB : cB + (size_t)(t + 2) * kstep;
            const char* a3 = a2 + kstep; const char* b3 = b2 + kstep;
            if (last && has_next) S.a_ready(nxt);
            PG8_LDB(B0, 0, 0); PG8_SCHED; PG8_LDA(At, 0, 0); PG8_STAGE(PG8_SA(1, 1), a1 + hstep, voffA);
            PG8_WAIT_L(8); PG8_BAR; PG8_WAIT_L(0); PG8_MMA(0, 0, At, B0); PG8_BAR; PG8_SCHED;
            PG8_LDB(B1, 0, 1); PG8_STAGE(PG8_SB(0, 0), b2, voffB);
            PG8_BAR; PG8_WAIT_L(0); PG8_MMA(0, 1, At, B1); PG8_BAR;
            PG8_LDA(At, 0, 1); PG8_STAGE(PG8_SA(0, 0), a2, voffA);
            PG8_BAR; PG8_WAIT_L(0); PG8_MMA(1, 0, At, B0); PG8_BAR; PG8_SCHED;
            PG8_STAGE(PG8_SB(0, 1), b2 + hstep, voffB);
            PG8_WAIT_V(6); PG8_BAR; PG8_MMA(1, 1, At, B1); PG8_BAR;
            PG8_LDB(B0, 1, 0); PG8_SCHED; PG8_LDA(At, 1, 0); PG8_STAGE(PG8_SA(0, 1), a2 + hstep, voffA);
            PG8_WAIT_L(8); PG8_BAR; PG8_WAIT_L(0); PG8_MMA(0, 0, At, B0); PG8_BAR; PG8_SCHED;
            PG8_LDB(B1, 1, 1); PG8_STAGE(PG8_SB(1, 0), b3, voffB);
            PG8_BAR; PG8_WAIT_L(0); PG8_MMA(0, 1, At, B1); PG8_BAR;
            PG8_LDA(At, 1, 1); PG8_STAGE(PG8_SA(1, 0), a3, voffA);
            PG8_BAR; PG8_WAIT_L(0); PG8_MMA(1, 0, At, B0); PG8_BAR; PG8_SCHED;
            PG8_STAGE(PG8_SB(1, 1), b3 + hstep, voffB);
            PG8_WAIT_V(6); PG8_BAR; PG8_MMA(1, 1, At, B1); PG8_BAR;
        }
        E(acc, cur, wr, wc, fr, fq); S.done(cur);
        if (!has_next) break;
#pragma unroll
        for (int a = 0; a < 2; ++a)
#pragma unroll
            for (int b = 0; b < 2; ++b)
#pragma unroll
                for (int m = 0; m < 4; ++m)
#pragma unroll
                    for (int n = 0; n < 2; ++n) acc[a][b][m][n] = (f32x4){0.f, 0.f, 0.f, 0.f};
        cur = nxt; cA = nA; cB = nB; ++ui;
    }
    PG8_WAIT_V(0);
    if (wr == 0) PG8_BAR;
    PG8_BAR;
#undef PG8_SA
#undef PG8_SB
#undef PG8_STAGE
#undef PG8_LDA
#undef PG8_LDB
#undef PG8_MMA
#undef PG8_WAIT_V
#undef PG8_WAIT_L
#undef PG8_BAR
#undef PG8_SCHED
}
}

namespace att {
constexpr int NW = 8, QBLK = 32, KVBLK = 64, DV = 128;
constexpr float THR = 8.f;
#define SBAR() __builtin_amdgcn_sched_barrier(0)
DI int crow(int r, int hi) { return (r & 3) + 8 * (r >> 2) + 4 * hi; }
template <int DQK> DI int kswz(int row, int colB) { return row * (DQK * 2) + (colB ^ ((row & 7) << 4)); }
DI void partialSM(f32x16& p0, f32x16& p1, float& m_reg, float& mn, float& alpha, const float SCALE) {
  const float C = SCALE * 1.4426950408889634f;
  float pmax = p0[0];
#pragma unroll
  for (int r = 1; r < 16; ++r) pmax = fmaxf(pmax, p0[r]);
#pragma unroll
  for (int r = 0; r < 16; ++r) pmax = fmaxf(pmax, p1[r]);
  { auto rr = __builtin_amdgcn_permlane32_swap(__float_as_uint(pmax), __float_as_uint(pmax), false, false);
    pmax = fmaxf(__uint_as_float(rr[0]), __uint_as_float(rr[1])); }
  if (__builtin_expect(__all(pmax - m_reg <= THR / SCALE), 1)) { mn = m_reg; alpha = 1.f; }
  else { mn = fmaxf(m_reg, pmax); alpha = __builtin_amdgcn_exp2f((m_reg - mn) * C); m_reg = mn; }
  const float mnC = -mn * C;
#pragma unroll
  for (int r = 0; r < 16; ++r) p0[r] = fmaf(p0[r], C, mnC);
#pragma unroll
  for (int r = 0; r < 16; ++r) p1[r] = fmaf(p1[r], C, mnC);
#pragma unroll
  for (int r = 0; r < 16; ++r) p0[r] = __builtin_amdgcn_exp2f(p0[r]);
}
DI void finishSM(f32x16& p0, f32x16& p1, float alpha, float& l_reg, bf16x8& pa0, bf16x8& pa1, bf16x8& pa2, bf16x8& pa3) {
#pragma unroll
  for (int r = 0; r < 16; ++r) p1[r] = __builtin_amdgcn_exp2f(p1[r]);
  float ps = 0;
#pragma unroll
  for (int r = 0; r < 16; ++r) ps += p0[r];
#pragma unroll
  for (int r = 0; r < 16; ++r) ps += p1[r];
  { auto rr = __builtin_amdgcn_permlane32_swap(__float_as_uint(ps), __float_as_uint(ps), false, false);
    ps = __uint_as_float(rr[0]) + __uint_as_float(rr[1]); }
  l_reg = l_reg * alpha + ps;
#define PK4(P, BASE, OUT) do { unsigned a0 = cvtpk(P[BASE + 0], P[BASE + 1]), a1 = cvtpk(P[BASE + 2], P[BASE + 3]);   \
    unsigned b0 = cvtpk(P[BASE + 4], P[BASE + 5]), b1 = cvtpk(P[BASE + 6], P[BASE + 7]);                              \
    auto r0 = __builtin_amdgcn_permlane32_swap(a0, b0, false, false); auto r1 = __builtin_amdgcn_permlane32_swap(a1, b1, false, false); \
    u32x4 w = {r0[0], r1[0], r0[1], r1[1]}; OUT = *reinterpret_cast<bf16x8*>(&w); } while (0)
  PK4(p0, 0, pa0); PK4(p0, 8, pa1); PK4(p1, 0, pa2); PK4(p1, 8, pa3);
#undef PK4
}
template <int DQK> DI void qkt(f32x16& p0, f32x16& p1, const LAS char* Ks, const bf16x8* qr, int r32, int hi) {
  p0 = f32x16{}; p1 = f32x16{};
#pragma unroll
  for (int d0 = 0; d0 < DQK / 16; ++d0) { const int cb = (d0 * 16 + hi * 8) * 2;
    const bf16x8 b0 = *(const LAS bf16x8*)(Ks + kswz<DQK>(r32, cb));
    const bf16x8 b1 = *(const LAS bf16x8*)(Ks + kswz<DQK>(32 + r32, cb));
    p0 = __builtin_amdgcn_mfma_f32_32x32x16_bf16(b0, qr[d0], p0, 0, 0, 0);
    p1 = __builtin_amdgcn_mfma_f32_32x32x16_bf16(b1, qr[d0], p1, 0, 0, 0); }
}
DI int v_st(int k, int c) { const int kk = (k & ~0xC) | ((k & 4) << 1) | ((k & 8) >> 1); return ((kk >> 3) * 4 + (c >> 5)) * 512 + ((kk & 7) * 32 + (c & 31)) * 2; }
DI int v_rd_base(int lane) { return ((lane & 3) << 3) | (((lane >> 2) & 3) << 6) | (((lane >> 4) & 1) << 5) | (((lane >> 5) & 1) << 8); }
constexpr int v_rd_off(int d0, int ks, int half) { return d0 * 512 + ks * 4096 + half * 2048; }
template <int OFF> DI s16x4 tr_read(int vb) { s16x4 r; asm volatile("ds_read_b64_tr_b16 %0, %1 offset:%2" : "=&v"(r) : "v"(vb), "i"(OFF) : "memory"); return r; }
template <int D0> DI void pv_one(f32x16& od, int vb, bf16x8 pa0, bf16x8 pa1, bf16x8 pa2, bf16x8 pa3) {
  const s16x4 l0 = tr_read<v_rd_off(D0, 0, 0)>(vb), h0 = tr_read<v_rd_off(D0, 0, 1)>(vb), l1 = tr_read<v_rd_off(D0, 1, 0)>(vb), h1 = tr_read<v_rd_off(D0, 1, 1)>(vb);
  const s16x4 l2 = tr_read<v_rd_off(D0, 2, 0)>(vb), h2 = tr_read<v_rd_off(D0, 2, 1)>(vb), l3 = tr_read<v_rd_off(D0, 3, 0)>(vb), h3 = tr_read<v_rd_off(D0, 3, 1)>(vb);
  asm volatile("s_waitcnt lgkmcnt(0)" ::: "memory"); SBAR();
#define PK(L, H) (bf16x8){L[0], L[1], L[2], L[3], H[0], H[1], H[2], H[3]}
  od = __builtin_amdgcn_mfma_f32_32x32x16_bf16(pa0, PK(l0, h0), od, 0, 0, 0);
  od = __builtin_amdgcn_mfma_f32_32x32x16_bf16(pa1, PK(l1, h1), od, 0, 0, 0);
  od = __builtin_amdgcn_mfma_f32_32x32x16_bf16(pa2, PK(l2, h2), od, 0, 0, 0);
  od = __builtin_amdgcn_mfma_f32_32x32x16_bf16(pa3, PK(l3, h3), od, 0, 0, 0);
#undef PK
}
DI void pv_d0(f32x16* o, int vb, bf16x8 pa0, bf16x8 pa1, bf16x8 pa2, bf16x8 pa3) {
  pv_one<0>(o[0], vb, pa0, pa1, pa2, pa3); pv_one<1>(o[1], vb, pa0, pa1, pa2, pa3); pv_one<2>(o[2], vb, pa0, pa1, pa2, pa3); pv_one<3>(o[3], vb, pa0, pa1, pa2, pa3);
}
template <int DQK> constexpr int lds_bytes() { return 2 * KVBLK * DV * 2 + 2 * KVBLK * DQK * 2 + NW * 64 * 4; }
template <int DQK, int SDEPTH, bool OUT_BF16>
DI void attn_body(const bf16_t* __restrict__ Qb, const bf16_t* __restrict__ Kh, const bf16_t* __restrict__ Vh, void* __restrict__ Obv, int ldo, int seq, LAS char* lds, const int tid) {
  constexpr int SHM_V = KVBLK * DV * 2, SHM_K = KVBLK * DQK * 2, NKC = DQK / 64, CPR = DQK / 8;
  const float SCALE = (DQK == 64) ? 0.125f : ((DQK == 128) ? 0.088388347648318440f : 0.072168783648703220f);
  const int wid = tid >> 6, lane = tid & 63, r32 = lane & 31, hi = lane >> 5;
  LAS char* V_lds = lds; LAS char* K_lds = lds + 2 * SHM_V;
  LAS float* ws = (LAS float*)(lds + 2 * SHM_V + 2 * SHM_K) + wid * 64; LAS float* li_l = ws; LAS float* al_l = ws + 32;
  float m_reg = -1e30f, l_reg = 0; f32x16 o[4] = {}; bf16x8 qr[DQK / 16];
  const bf16_t* Qw = Qb + (long)(wid * QBLK + r32) * DQK + hi * 8;
#pragma unroll
  for (int d0 = 0; d0 < DQK / 16; ++d0) qr[d0] = *reinterpret_cast<const bf16x8*>(Qw + d0 * 16);
  const int sr = tid >> 4, sc = (tid & 15) * 8, vst0 = v_st(sr, sc), vst1 = v_st(32 + sr, sc);
  int krow[NKC], kcol[NKC];
#pragma unroll
  for (int i = 0; i < NKC; ++i) { const int ci = tid + i * 512; krow[i] = ci / CPR; kcol[i] = (ci % CPR) * 8; }
  const int vb0 = (int)(uintptr_t)V_lds + v_rd_base(lane);
  struct { bf16x8 vs0, vs1, ks[NKC]; } sr_[SDEPTH];
#define SLOAD(i, k0) do { sr_[i].vs0 = *reinterpret_cast<const bf16x8*>(&Vh[(long)((k0) + sr) * DV + sc]); sr_[i].vs1 = *reinterpret_cast<const bf16x8*>(&Vh[(long)((k0) + 32 + sr) * DV + sc]); \
    _Pragma("unroll") for (int _c = 0; _c < NKC; ++_c) sr_[i].ks[_c] = *reinterpret_cast<const bf16x8*>(&Kh[(long)((k0) + krow[_c]) * DQK + kcol[_c]]); } while (0)
#define SWRITE(b, i) do { *(LAS bf16x8*)(V_lds + (b) * SHM_V + vst0) = sr_[i].vs0; *(LAS bf16x8*)(V_lds + (b) * SHM_V + vst1) = sr_[i].vs1; \
    _Pragma("unroll") for (int _c = 0; _c < NKC; ++_c) *(LAS bf16x8*)(K_lds + (b) * SHM_K + kswz<DQK>(krow[_c], kcol[_c] * 2)) = sr_[i].ks[_c]; } while (0)
#define SWAIT() do { if constexpr (SDEPTH == 2) { if constexpr (NKC == 1) asm volatile("s_waitcnt vmcnt(3)" ::: "memory"); else if constexpr (NKC == 2) asm volatile("s_waitcnt vmcnt(4)" ::: "memory"); else asm volatile("s_waitcnt vmcnt(5)" ::: "memory"); } \
    else asm volatile("s_waitcnt vmcnt(0)" ::: "memory"); } while (0)
#define RESC(a) do { if (__any((a) < 1.f)) { if (hi == 0) al_l[r32] = (a); asm volatile("s_waitcnt lgkmcnt(0)" ::: "memory"); \
    _Pragma("unroll") for (int d = 0; d < 4; ++d) _Pragma("unroll") for (int r = 0; r < 16; ++r) o[d][r] *= al_l[crow(r, hi)]; } } while (0)
  f32x16 pA0, pA1, pB0, pB1; float mnA, mnB, alA, alB; bf16x8 pa0, pa1, pa2, pa3; const int NT = seq / KVBLK;
  constexpr int SE = 0, SO = SDEPTH - 1;
  SLOAD(SE, 0); asm volatile("s_waitcnt vmcnt(0)" ::: "memory"); SWRITE(0, SE); __syncthreads();
  qkt<DQK>(pA0, pA1, K_lds, qr, r32, hi); partialSM(pA0, pA1, m_reg, mnA, alA, SCALE);
  SLOAD(SO, KVBLK); if constexpr (SDEPTH == 2) { if (2 < NT) SLOAD(SE, 2 * KVBLK); }
  SWAIT(); SWRITE(1, SO); __syncthreads();
  for (int j = 1; j + 1 < NT; j += 2) {
    SBAR(); qkt<DQK>(pB0, pB1, K_lds + SHM_K, qr, r32, hi);
    finishSM(pA0, pA1, alA, l_reg, pa0, pa1, pa2, pa3); SBAR();
    SLOAD(SO, (j + SDEPTH) * KVBLK); SBAR();
    pv_d0(o, vb0, pa0, pa1, pa2, pa3); partialSM(pB0, pB1, m_reg, mnB, alB, SCALE);
    __syncthreads(); SWAIT(); SWRITE(0, SE);
    RESC(alB); __syncthreads();
    SBAR(); qkt<DQK>(pA0, pA1, K_lds, qr, r32, hi);
    finishSM(pB0, pB1, alB, l_reg, pa0, pa1, pa2, pa3); SBAR();
    if (SDEPTH == 1 || j + 3 < NT) SLOAD(SE, (j + 1 + SDEPTH) * KVBLK); SBAR();
    pv_d0(o, vb0 + SHM_V, pa0, pa1, pa2, pa3); partialSM(pA0, pA1, m_reg, mnA, alA, SCALE);
    __syncthreads(); SWAIT(); SWRITE(1, SO);
    RESC(alA); __syncthreads();
  }
  SBAR(); qkt<DQK>(pB0, pB1, K_lds + SHM_K, qr, r32, hi);
  finishSM(pA0, pA1, alA, l_reg, pa0, pa1, pa2, pa3); SBAR();
  pv_d0(o, vb0, pa0, pa1, pa2, pa3); partialSM(pB0, pB1, m_reg, mnB, alB, SCALE);
  __syncthreads(); RESC(alB);
  finishSM(pB0, pB1, alB, l_reg, pa0, pa1, pa2, pa3); SBAR();
  pv_d0(o, vb0 + SHM_V, pa0, pa1, pa2, pa3);
  if (hi == 0) li_l[r32] = l_reg; asm volatile("s_waitcnt lgkmcnt(0)" ::: "memory");
  float rli[16];
#pragma unroll
  for (int r = 0; r < 16; ++r) rli[r] = __builtin_amdgcn_rcpf(li_l[crow(r, hi)]);
  if constexpr (OUT_BF16) {
    bf16_t* Ow = (bf16_t*)Obv + (long)(wid * QBLK) * ldo;
#pragma unroll
    for (int r = 0; r < 16; ++r) { const int orow = crow(r, hi);
#pragma unroll
      for (int d0 = 0; d0 < 4; ++d0) Ow[(long)orow * ldo + d0 * 32 + r32] = f2bf(o[d0][r] * rli[r]); }
  } else {
    float* Ow = (float*)Obv + (long)(wid * QBLK) * ldo;
#pragma unroll
    for (int r = 0; r < 16; ++r) { const int orow = crow(r, hi);
#pragma unroll
      for (int d0 = 0; d0 < 4; ++d0) Ow[(long)orow * ldo + d0 * 32 + r32] = o[d0][r] * rli[r]; }
  }
  __syncthreads();
#undef SLOAD
#undef SWRITE
#undef SWAIT
#undef RESC
}

template <int DQK, bool OUT_BF16>
DI void attn_body1(const bf16_t* __restrict__ Qb, const bf16_t* __restrict__ Kh, const bf16_t* __restrict__ Vh, void* __restrict__ Obv, int ldo, int seq, LAS char* lds, const int tid) {
  constexpr int SHM_V = KVBLK * DV * 2, SHM_K = KVBLK * DQK * 2, NKC = DQK / 64, CPR = DQK / 8;
  const float SCALE = (DQK == 64) ? 0.125f : ((DQK == 128) ? 0.088388347648318440f : 0.072168783648703220f);
  const int wid = tid >> 6, lane = tid & 63, r32 = lane & 31, hi = lane >> 5;
  LAS char* V_lds = lds; LAS char* K_lds = lds + 2 * SHM_V;
  LAS float* ws = (LAS float*)(lds + 2 * SHM_V + 2 * SHM_K) + wid * 64; LAS float* li_l = ws; LAS float* al_l = ws + 32;
  constexpr int QREG = (DQK / 16 > 8) ? 8 : DQK / 16, QLDS = DQK / 16 - QREG;
  LAS char* Qp = lds + 2 * SHM_V + 2 * SHM_K + NW * 64 * 4 + wid * (QLDS * 1024) + lane * 16;
  float m_reg = -1e30f, l_reg = 0; f32x16 o[4] = {}; bf16x8 qr[QREG];
  const bf16_t* Qw = Qb + (long)(wid * QBLK + r32) * DQK + hi * 8;
#pragma unroll
  for (int d0 = 0; d0 < QREG; ++d0) qr[d0] = *reinterpret_cast<const bf16x8*>(Qw + d0 * 16);
#pragma unroll
  for (int d0 = 0; d0 < QLDS; ++d0) *(LAS bf16x8*)(Qp + d0 * 1024) = *reinterpret_cast<const bf16x8*>(Qw + (QREG + d0) * 16);
  const int sr = tid >> 4, sc = (tid & 15) * 8, vst0 = v_st(sr, sc), vst1 = v_st(32 + sr, sc);
  int krow[NKC], kcol[NKC];
#pragma unroll
  for (int i = 0; i < NKC; ++i) { const int ci = tid + i * 512; krow[i] = ci / CPR; kcol[i] = (ci % CPR) * 8; }
  const int vb0 = (int)(uintptr_t)V_lds + v_rd_base(lane);
  bf16x8 vs0, vs1, ks[NKC];
#define SLOAD1(k0) do { vs0 = *reinterpret_cast<const bf16x8*>(&Vh[(long)((k0) + sr) * DV + sc]); vs1 = *reinterpret_cast<const bf16x8*>(&Vh[(long)((k0) + 32 + sr) * DV + sc]); \
    _Pragma("unroll") for (int _c = 0; _c < NKC; ++_c) ks[_c] = *reinterpret_cast<const bf16x8*>(&Kh[(long)((k0) + krow[_c]) * DQK + kcol[_c]]); } while (0)
#define SWRITE1(b) do { *(LAS bf16x8*)(V_lds + (b) * SHM_V + vst0) = vs0; *(LAS bf16x8*)(V_lds + (b) * SHM_V + vst1) = vs1; \
    _Pragma("unroll") for (int _c = 0; _c < NKC; ++_c) *(LAS bf16x8*)(K_lds + (b) * SHM_K + kswz<DQK>(krow[_c], kcol[_c] * 2)) = ks[_c]; } while (0)
  const int NT = seq / KVBLK;
  SLOAD1(0); asm volatile("s_waitcnt vmcnt(0)" ::: "memory"); SWRITE1(0); __syncthreads();
  for (int j = 0; j < NT; ++j) {
    const int b = j & 1; f32x16 p0, p1; float mn, al; bf16x8 pa0, pa1, pa2, pa3;
    if (j + 1 < NT) SLOAD1((j + 1) * KVBLK);
    SBAR();
    { const LAS char* Ks = K_lds + b * SHM_K; p0 = f32x16{}; p1 = f32x16{};
#pragma unroll
      for (int d0 = 0; d0 < DQK / 16; ++d0) { const int cb = (d0 * 16 + hi * 8) * 2;
        const bf16x8 b0 = *(const LAS bf16x8*)(Ks + kswz<DQK>(r32, cb)); const bf16x8 b1 = *(const LAS bf16x8*)(Ks + kswz<DQK>(32 + r32, cb));
        bf16x8 qf; if (d0 < QREG) qf = qr[d0 < QREG ? d0 : 0]; else qf = *(const LAS bf16x8*)(Qp + (d0 - QREG) * 1024);
        p0 = __builtin_amdgcn_mfma_f32_32x32x16_bf16(b0, qf, p0, 0, 0, 0); p1 = __builtin_amdgcn_mfma_f32_32x32x16_bf16(b1, qf, p1, 0, 0, 0); } }
    partialSM(p0, p1, m_reg, mn, al, SCALE);
    if (__any(al < 1.f)) { if (hi == 0) al_l[r32] = al; asm volatile("s_waitcnt lgkmcnt(0)" ::: "memory");
#pragma unroll
      for (int d = 0; d < 4; ++d)
#pragma unroll
        for (int r = 0; r < 16; ++r) o[d][r] *= al_l[crow(r, hi)]; }
    finishSM(p0, p1, al, l_reg, pa0, pa1, pa2, pa3); SBAR();
    pv_d0(o, vb0 + b * SHM_V, pa0, pa1, pa2, pa3);
    if (j + 1 < NT) { asm volatile("s_waitcnt vmcnt(0)" ::: "memory"); SWRITE1(b ^ 1); }
    __syncthreads();
  }
  if (hi == 0) li_l[r32] = l_reg; asm volatile("s_waitcnt lgkmcnt(0)" ::: "memory");
  float rli[16];
#pragma unroll
  for (int r = 0; r < 16; ++r) rli[r] = __builtin_amdgcn_rcpf(li_l[crow(r, hi)]);
  if constexpr (OUT_BF16) {
    bf16_t* Ow = (bf16_t*)Obv + (long)(wid * QBLK) * ldo;
#pragma unroll
    for (int r = 0; r < 16; ++r) { const int orow = crow(r, hi);
#pragma unroll
      for (int d0 = 0; d0 < 4; ++d0) Ow[(long)orow * ldo + d0 * 32 + r32] = f2bf(o[d0][r] * rli[r]); }
  } else {
    float* Ow = (float*)Obv + (long)(wid * QBLK) * ldo;
#pragma unroll
    for (int r = 0; r < 16; ++r) { const int orow = crow(r, hi);
#pragma unroll
      for (int d0 = 0; d0 < 4; ++d0) Ow[(long)orow * ldo + d0 * 32 + r32] = o[d0][r] * rli[r]; }
  }
  __syncthreads();
#undef SLOAD1
#undef SWRITE1
}
}

constexpr int NWAVES = 8, NTHREADS = 512;
constexpr int LDS_BYTES = 144 * 1024;
struct Args { const float* in[N_INPUTS]; float* out; unsigned char* ws; int pro_lo, pro_hi, l_lo, l_hi, ph_lo, ph_hi, fused, pad; };
struct Frame {
    const float* const* in; float* out; unsigned char* ws; unsigned char* big;
    LAS unsigned char* lds; char* ldsg; int tid, lane, wave, wg, nwg, gw, ngw;
};

DI int win_map(int n) { if (n < 2048) return n; if (n < 4160) return n + 16; if (n < 4176) return n - 2112; if (n < 4352) return -1; return n - 176; }
DI void transpose_item(const float* __restrict__ src, int K, int ld, int Nsrc, bf16_t* __restrict__ dst, int Kp, bool wmap, int k0, int n0, float* tile, int tid) {
    const int nn = tid & 63, kk0 = tid >> 6; const int n = n0 + nn; const int sc = wmap ? win_map(n) : (n < Nsrc ? n : -1);
#pragma unroll
    for (int i = 0; i < 8; ++i) { const int kk = kk0 + 8 * i, k = k0 + kk; tile[kk * 65 + nn] = (k < K && sc >= 0) ? src[(size_t)k * ld + sc] : 0.f; }
    __syncthreads();
    const int wn = tid >> 3, kc = tid & 7; float f[8];
#pragma unroll
    for (int j = 0; j < 8; ++j) f[j] = tile[(kc * 8 + j) * 65 + wn];
    *(u32x4*)(dst + (size_t)(n0 + wn) * Kp + k0 + kc * 8) = pack8(f);
    __syncthreads();
}
DI void convert_layer(const Frame& F, int l) {
    float* tile = (float*)F.ldsg;
    constexpr int I_IN = (DM / 64) * (NP / 64), I_OUT = (DM / 64) * (DM / 64), I_UP = (DM / 64) * (NUP / 64), I_DN = (DFF / 64) * (DM / 64), I_UQ = (384 / 64) * (768 / 64), I_UKV = (256 / 64) * (1024 / 64);
    constexpr int NIT = I_IN + I_OUT + I_UP + I_DN + I_UQ + I_UKV;
    for (int it = F.wg; it < NIT; it += F.nwg) {
        int r = it;
        if (r < I_IN) { transpose_item(F.in[I_WIN] + (size_t)l * DM * NIN, DM, NIN, NIN, (bf16_t*)(F.ws + WS_WIN), DM, true, (r % (DM / 64)) * 64, (r / (DM / 64)) * 64, tile, F.tid); continue; } r -= I_IN;
        if (r < I_OUT) { transpose_item(F.in[I_WOUT] + (size_t)l * DM * DM, DM, DM, DM, (bf16_t*)(F.ws + WS_WOUT), DM, false, (r % (DM / 64)) * 64, (r / (DM / 64)) * 64, tile, F.tid); continue; } r -= I_OUT;
        if (r < I_UP) { transpose_item(F.in[I_WUP] + (size_t)l * DM * NUP, DM, NUP, NUP, (bf16_t*)(F.ws + WS_WUP), DM, false, (r % (DM / 64)) * 64, (r / (DM / 64)) * 64, tile, F.tid); continue; } r -= I_UP;
        if (r < I_DN) { transpose_item(F.in[I_WDN] + (size_t)l * DFF * DM, DFF, DM, DM, (bf16_t*)(F.ws + WS_WDN), DFF, false, (r % (DFF / 64)) * 64, (r / (DFF / 64)) * 64, tile, F.tid); continue; } r -= I_DN;
        if (r < I_UQ) { transpose_item(F.in[I_MWUQ] + (size_t)l * 384 * 768, 384, 768, 768, (bf16_t*)(F.ws + WS_WUQ), 384, false, (r % 6) * 64, (r / 6) * 64, tile, F.tid); continue; } r -= I_UQ;
        transpose_item(F.in[I_MWUKV] + (size_t)l * 128 * 1024, 128, 1024, 1024, (bf16_t*)(F.ws + WS_WUKV), 256, false, (r % 4) * 64, (r / 4) * 64, tile, F.tid);
    }
}

DI void pro_gemv(const Frame& F) {
    float* modp = (float*)(F.ws + WS_MODP);
    const float* c = F.in[I_C]; const float* cc = F.in[I_CCTX];
    for (int it = F.gw; it < 4 * 16 * 48; it += F.ngw) {
        const int l = it / 768, ks = (it / 48) % 16, cg = it % 48; const int n = cg * 256 + F.lane * 4;
        const float* w = F.in[I_WMOD] + (size_t)l * DM * 12288 + n;
        f32x4 a0 = {0, 0, 0, 0}, a1 = a0, a2 = a0;
        for (int k = ks * 128; k < ks * 128 + 128; ++k) {
            const f32x4 wv = *(const f32x4*)(w + (size_t)k * 12288);
            const float s0 = silu_f(c[k]), s1 = silu_f(c[DM + k]), s2 = silu_f(cc[k]);
            a0 += wv * s0; a1 += wv * s1; a2 += wv * s2;
        }
        float* o = modp + ((size_t)(ks * 4 + l) * 3) * 12288 + n;
        *(f32x4*)(o) = a0; *(f32x4*)(o + 12288) = a1; *(f32x4*)(o + 2 * 12288) = a2;
    }
    f32x2* rt = (f32x2*)(F.ws + WS_RTAB);
    for (int i = F.wg * NTHREADS + F.tid; i < 128 * 16; i += F.nwg * NTHREADS) {
        const int pos = i >> 4, fi = i & 15; const float inv = exp2f(-(float)fi * (13.287712379549449f / 16.f)); const float ang = (float)pos * inv;
        rt[i] = (f32x2){cosf(ang), sinf(ang)};
    }
}
DI void pro_modreduce(const Frame& F) {
    const float* modp = (const float*)(F.ws + WS_MODP); float* mod = (float*)(F.ws + WS_MOD);
    for (int i = F.wg * NTHREADS + F.tid; i < 4 * 3 * 12288; i += F.nwg * NTHREADS) {
        const int l = i / (3 * 12288), n = i % 12288;
        float s = F.in[I_BMOD][l * 12288 + n];
        for (int ks = 0; ks < 16; ++ks) s += modp[(size_t)ks * 4 * 3 * 12288 + i];
        mod[i] = s;
    }
}
DI const float* x_row_in(const Frame& F, int r) { return r < MLAT ? F.in[I_X] + (size_t)r * DM : F.in[I_CTX] + (size_t)(r - MLAT) * DM; }
DI const float* modv(const Frame& F, int l, int mr, int j) { return (const float*)(F.ws + WS_MOD) + ((size_t)(l * 3 + mr) * 6 + j) * DM; }
DI void pro_h0(const Frame& F) {
    bf16_t* h = (bf16_t*)(F.ws + WS_H);
    for (int r = F.gw; r < MT; r += F.ngw) {
        const RowInfo ri = row_info(r); const float* x = x_row_in(F, r); const float* m0 = modv(F, 0, ri.mr, 0); const float* m1 = modv(F, 0, ri.mr, 1);
#pragma unroll
        for (int i = 0; i < 4; ++i) { const int c = (i * 64 + F.lane) * 8; float f[8];
            const f32x4 a = *(const f32x4*)(x + c), b = *(const f32x4*)(x + c + 4), s0 = *(const f32x4*)(m1 + c), s1 = *(const f32x4*)(m1 + c + 4), t0 = *(const f32x4*)(m0 + c), t1 = *(const f32x4*)(m0 + c + 4);
#pragma unroll
            for (int j = 0; j < 4; ++j) { f[j] = a[j] * (1.f + s0[j]) + t0[j]; f[4 + j] = b[j] * (1.f + s1[j]) + t1[j]; }
            *(u32x4*)(h + (size_t)r * DM + c) = pack8(f); }
    }
}

DI void rope_pair(float& a, float& b, const f32x2 cs) { const float x1 = a, x2 = b; a = x1 * cs.x - x2 * cs.y; b = x1 * cs.y + x2 * cs.x; }
DI void prep_rows(const Frame& F, int l) {
    const bf16_t* p = (const bf16_t*)(F.big + WB_P);
    float* gate = (float*)(F.big + WB_GATE);
    bf16_t* Qd = (bf16_t*)(F.big + WB_QD); bf16_t* Kd = (bf16_t*)(F.big + WB_KD); bf16_t* Vd = (bf16_t*)(F.big + WB_VD);
    bf16_t* cq = (bf16_t*)(F.big + WB_CQ); bf16_t* ckv = (bf16_t*)(F.big + WB_CKV); bf16_t* krope = (bf16_t*)(F.big + WB_KROPE);
    const f32x2* rt = (const f32x2*)(F.ws + WS_RTAB);
    const float* gconv = F.in[I_GCONV] + (size_t)l * 3 * 1536;
    const int lane = F.lane;
    for (int r = F.gw; r < MT; r += F.ngw) {
        const RowInfo ri = row_info(r); const bf16_t* pr = p + (size_t)r * NP;
        const bool hasm = ri.t > 0, hasn = ri.t < ri.len - 1;
#pragma unroll
        for (int i = 0; i < 3; ++i) {
            const int c0 = (i * 64 + lane) * 8; float xc[8], xm[8], xn[8], y[8];
            unpack8(*(const u32x4*)(pr + c0), xc);
            if (hasm) unpack8(*(const u32x4*)(pr - NP + c0), xm); else { for (int j = 0; j < 8; ++j) xm[j] = 0.f; }
            if (hasn) unpack8(*(const u32x4*)(pr + NP + c0), xn); else { for (int j = 0; j < 8; ++j) xn[j] = 0.f; }
            float ss = 0.f;
#pragma unroll
            for (int j = 0; j < 8; ++j) { const float v = gconv[c0 + j] * xm[j] + gconv[1536 + c0 + j] * xc[j] + gconv[2 * 1536 + c0 + j] * xn[j]; y[j] = silu_f(v); ss += y[j] * y[j]; }
            if (i < 2) { ss = grp16_sum(ss); const float sc = rsqrtf(ss + RMS_EPS) * (i == 0 ? 0.08838834764831845f : 1.f);
#pragma unroll
                for (int j = 0; j < 8; ++j) y[j] *= sc; }
            *(u32x4*)((bf16_t*)(F.big + WB_GQB) + (size_t)r * 1536 + c0) = pack8(y);
        }
        if (lane < 16) {
            const float x = bf2f(pr[PC_GAB + lane]); const int dh = lane & 7; float g;
            if (lane < 8) g = -__expf(F.in[I_GALOG][l * 8 + dh]) * softplus_f(x + F.in[I_GDT][l * 8 + dh]); else g = sigmoid_f(x);
            gate[(size_t)r * 16 + lane] = g;
        }
        const int prow = ri.t >> 6, pcol = ri.t & 63;
        {
            const int hs = lane >> 3, e = lane & 7, h = hs >> 1, sub = hs & 1; const int hd = (ri.b * 4 + h) * 2 + sub;
#pragma unroll
            for (int qk = 0; qk < 2; ++qk) {
                const bf16_t* s = pr + PC_DIFF + qk * 512 + h * 128 + sub * 64 + 2 * e;
                const unsigned w0 = *(const unsigned*)(s), w1 = *(const unsigned*)(s + 16), w2 = *(const unsigned*)(s + 32), w3 = *(const unsigned*)(s + 48);
                float a0 = bflo(w0), a1 = bfhi(w0), b0 = bflo(w1), b1 = bfhi(w1), c0 = bflo(w2), c1 = bfhi(w2), d0 = bflo(w3), d1 = bfhi(w3);
                if (!ri.ctx) { rope_pair(a0, b0, rt[prow * 16 + 2 * e]); rope_pair(a1, b1, rt[prow * 16 + 2 * e + 1]); rope_pair(c0, d0, rt[pcol * 16 + 2 * e]); rope_pair(c1, d1, rt[pcol * 16 + 2 * e + 1]); }
                bf16_t* d = (qk == 0 ? Qd : Kd) + ((size_t)hd * LTOT + ri.tok) * 64 + 2 * e;
                *(unsigned*)(d) = cvtpk(a0, a1); *(unsigned*)(d + 16) = cvtpk(b0, b1); *(unsigned*)(d + 32) = cvtpk(c0, c1); *(unsigned*)(d + 48) = cvtpk(d0, d1);
            }
            const int hv = lane >> 4, dv0 = (lane & 15) * 8;
            *(u32x4*)(Vd + ((size_t)(ri.b * 4 + hv) * LTOT + ri.tok) * 128 + dv0) = *(const u32x4*)(pr + PC_DIFF + 1024 + hv * 128 + dv0);
        }
        {
            float v[6]; float ss = 0.f;
#pragma unroll
            for (int i = 0; i < 3; ++i) { const unsigned w = *(const unsigned*)(pr + PC_MLA + 2 * (lane + 64 * i)); v[2 * i] = bflo(w); v[2 * i + 1] = bfhi(w); ss += v[2 * i] * v[2 * i] + v[2 * i + 1] * v[2 * i + 1]; }
            ss = wave_sum(ss); const float rs = rsqrtf(ss * (1.f / 384.f) + RMS_EPS); const float* g = F.in[I_MQN] + l * 384;
#pragma unroll
            for (int i = 0; i < 3; ++i) { const int c = 2 * (lane + 64 * i); *(unsigned*)(cq + (size_t)r * 384 + c) = cvtpk(v[2 * i] * rs * g[c], v[2 * i + 1] * rs * g[c + 1]); }
            const unsigned w = *(const unsigned*)(pr + PC_MLA + 384 + 2 * lane); const float k0 = bflo(w), k1 = bfhi(w);
            float s2 = wave_sum(k0 * k0 + k1 * k1); const float rs2 = rsqrtf(s2 * (1.f / 128.f) + RMS_EPS); const float* g2 = F.in[I_MKVN] + l * 128;
            *(unsigned*)(ckv + (size_t)r * 256 + 2 * lane) = cvtpk(k0 * rs2 * g2[2 * lane], k1 * rs2 * g2[2 * lane + 1]);
            *(unsigned*)(ckv + (size_t)r * 256 + 128 + 2 * lane) = 0u;
            if (lane < 16) {
                const bf16_t* s = pr + PC_MLA + 512; float a = bf2f(s[lane]), b = bf2f(s[16 + lane]), c = bf2f(s[32 + lane]), d = bf2f(s[48 + lane]);
                if (!ri.ctx) { rope_pair(a, b, rt[prow * 16 + lane]); rope_pair(c, d, rt[pcol * 16 + lane]); }
                bf16_t* o = krope + (size_t)r * 64; o[lane] = f2bf(a); o[16 + lane] = f2bf(b); o[32 + lane] = f2bf(c); o[48 + lane] = f2bf(d);
            }
        }
    }
}
DI void mla_assemble(const Frame& F) {
    const bf16_t* qraw = (const bf16_t*)(F.big + WB_QRAW); const bf16_t* kvraw = (const bf16_t*)(F.big + WB_KVRAW); const bf16_t* krope = (const bf16_t*)(F.big + WB_KROPE);
    bf16_t* Qm = (bf16_t*)(F.big + WB_QM); bf16_t* Km = (bf16_t*)(F.big + WB_KM); bf16_t* Vm = (bf16_t*)(F.big + WB_VM);
    const f32x2* rt = (const f32x2*)(F.ws + WS_RTAB); const int lane = F.lane;
    for (int r = F.gw; r < MT; r += F.ngw) {
        const RowInfo ri = row_info(r); const int prow = ri.t >> 6, pcol = ri.t & 63;
        const bf16_t kr = krope[(size_t)r * 64 + lane];
#pragma unroll
        for (int h = 0; h < 4; ++h) {
            const size_t o = (size_t)(ri.b * 4 + h) * LTOT + ri.tok;
            const bf16_t* q = qraw + (size_t)r * 768 + h * 192; const bf16_t* kv = kvraw + (size_t)r * 1024 + h * 256;
            *(unsigned*)(Qm + o * 192 + 2 * lane) = *(const unsigned*)(q + 2 * lane);
            if (lane < 16) { float a = bf2f(q[128 + lane]), b = bf2f(q[144 + lane]), c = bf2f(q[160 + lane]), d = bf2f(q[176 + lane]);
                if (!ri.ctx) { rope_pair(a, b, rt[prow * 16 + lane]); rope_pair(c, d, rt[pcol * 16 + lane]); }
                bf16_t* qo = Qm + o * 192 + 128; qo[lane] = f2bf(a); qo[16 + lane] = f2bf(b); qo[32 + lane] = f2bf(c); qo[48 + lane] = f2bf(d); }
            *(unsigned*)(Km + o * 192 + 2 * lane) = *(const unsigned*)(kv + 2 * lane);
            Km[o * 192 + 128 + lane] = kr;
            *(unsigned*)(Vm + o * 128 + 2 * lane) = *(const unsigned*)(kv + 128 + 2 * lane);
        }
    }
}
DI void attn_diff_phase(const Frame& F) {
    const bf16_t* Qd = (const bf16_t*)(F.big + WB_QD); const bf16_t* Kd = (const bf16_t*)(F.big + WB_KD); const bf16_t* Vd = (const bf16_t*)(F.big + WB_VD); float* Od = (float*)(F.big + WB_OD);
    for (int u = F.wg; u < 16 * 33; u += F.nwg) {
        const int hd = u / 33, qb = u % 33;
        const int bh = hd >> 1, sub = hd & 1, b = bh >> 2, h = bh & 3;
        const bool ctx = qb == 32; const int tok0 = ctx ? 0 : CTX + qb * 256; const int row0 = ctx ? MLAT + b * CTX : b * SEQ + qb * 256;
        att::attn_body<64, 2, false>(Qd + ((size_t)hd * LTOT + tok0) * 64, Kd + (size_t)hd * LTOT * 64, Vd + (size_t)bh * LTOT * 128,
                                     Od + ((size_t)sub * MT + row0) * 512 + h * 128, 512, ctx ? CTX : LTOT, (LAS char*)F.lds, F.tid);
    }
}
DI void attn_mla_phase(const Frame& F) {
    const bf16_t* Qm = (const bf16_t*)(F.big + WB_QM); const bf16_t* Km = (const bf16_t*)(F.big + WB_KM); const bf16_t* Vm = (const bf16_t*)(F.big + WB_VM); bf16_t* mix = (bf16_t*)(F.ws + WS_MIX);
    for (int u = F.wg; u < 8 * 33; u += F.nwg) {
        const int bh = u / 33, qb = u % 33, b = bh >> 2, h = bh & 3;
        const bool ctx = qb == 32; const int tok0 = ctx ? 0 : CTX + qb * 256; const int row0 = ctx ? MLAT + b * CTX : b * SEQ + qb * 256;
        att::attn_body1<192, true>(Qm + ((size_t)bh * LTOT + tok0) * 192, Km + (size_t)bh * LTOT * 192, Vm + (size_t)bh * LTOT * 128,
                                     mix + (size_t)row0 * DM + 1024 + h * 128, DM, ctx ? CTX : LTOT, (LAS char*)F.lds, F.tid);
    }
}

namespace att {
DI void na_body(const bf16_t* __restrict__ p, const float* __restrict__ rpb_h, bf16_t* __restrict__ mix, int b, int h, int rq  , LAS char* lds, const int tid) {
  constexpr int DQK = 128, SHM_V = KVBLK * DV * 2, SHM_K = KVBLK * DQK * 2;
  constexpr float SCALE = 0.088388347648318440f, ISCALE = 11.313708498984761f;
  const int wid = tid >> 6, lane = tid & 63, r32 = lane & 31, hi = lane >> 5;
  LAS char* V_lds = lds; LAS char* K_lds = lds + 2 * SHM_V;
  LAS float* ws = (LAS float*)(lds + 2 * SHM_V + 2 * SHM_K) + wid * 64; LAS float* li_l = ws; LAS float* al_l = ws + 32;
  LAS float* rpb_l = (LAS float*)(lds + 2 * SHM_V + 2 * SHM_K + NW * 64 * 4);
  const bool ctxq = rq == 32;
  for (int i = tid; i < 15 * 31; i += 512) rpb_l[i] = rpb_h[i] * ISCALE;
  const int qrow0 = ctxq ? MLAT + b * CTX : b * SEQ + rq * 256;
  const int qr = 4 * rq + (wid >> 1), qc = 32 * (wid & 1) + r32;
  const int rs_q = min(max(qr - 4, 0), 120), cs_q = min(max(qc - 8, 0), 48);
  const int rs0 = min(max(4 * rq - 4, 0), 120), rs3 = min(max(4 * rq + 3 - 4, 0), 120);
  const int nnb = ctxq ? 0 : rs3 - rs0 + 8, NT = nnb + 4;
  float m_reg = -1e30f, l_reg = 0; f32x16 o[4] = {}; bf16x8 qr_[8];
  const bf16_t* Qw = p + (size_t)(qrow0 + wid * QBLK + r32) * NP + PC_NA + h * 128 + hi * 8;
#pragma unroll
  for (int d0 = 0; d0 < 8; ++d0) qr_[d0] = *reinterpret_cast<const bf16x8*>(Qw + d0 * 16);
  const int sr = tid >> 4, sc = (tid & 15) * 8, vst0 = v_st(sr, sc), vst1 = v_st(32 + sr, sc);
  const int vb0 = (int)(uintptr_t)V_lds + v_rd_base(lane);
  const bf16_t* Kp = p + PC_NA + 512 + h * 128 + sc; const bf16_t* Vp = p + PC_NA + 1024 + h * 128 + sc;
  bf16x8 vs0, vs1, ks0, ks1;
#define NA_TROW(j) ((j) < nnb ? b * SEQ + (rs0 + (j)) * 64 : MLAT + b * CTX + ((j) - nnb) * 64)
#define NA_LOAD(j) do { const size_t r0_ = (size_t)(NA_TROW(j) + sr) * NP, r1_ = r0_ + (size_t)32 * NP; vs0 = *reinterpret_cast<const bf16x8*>(Vp + r0_); vs1 = *reinterpret_cast<const bf16x8*>(Vp + r1_); \
    ks0 = *reinterpret_cast<const bf16x8*>(Kp + r0_); ks1 = *reinterpret_cast<const bf16x8*>(Kp + r1_); } while (0)
#define NA_WRITE(bb) do { *(LAS bf16x8*)(V_lds + (bb) * SHM_V + vst0) = vs0; *(LAS bf16x8*)(V_lds + (bb) * SHM_V + vst1) = vs1; \
    *(LAS bf16x8*)(K_lds + (bb) * SHM_K + kswz<DQK>(sr, sc * 2)) = ks0; *(LAS bf16x8*)(K_lds + (bb) * SHM_K + kswz<DQK>(32 + sr, sc * 2)) = ks1; } while (0)
  NA_LOAD(0); asm volatile("s_waitcnt vmcnt(0)" ::: "memory"); NA_WRITE(0); __syncthreads();
  for (int j = 0; j < NT; ++j) {
    const int bb = j & 1;
    if (j + 1 < NT) NA_LOAD(j + 1);
    const int kr = rs0 + j; const bool nb = j < nnb;
    const bool active = !nb || (kr >= rs_q && kr < rs_q + 8);
    if (active) {
      f32x16 p0, p1; float mn, al; bf16x8 pa0, pa1, pa2, pa3;
      SBAR(); qkt<DQK>(p0, p1, K_lds + bb * SHM_K, qr_, r32, hi);
      if (nb) {
        const LAS float* brow = rpb_l + (kr - qr + 7) * 31 + 15 - qc;
#pragma unroll
        for (int r = 0; r < 16; ++r) { const int kc0 = crow(r, hi), kc1 = kc0 + 32;
          p0[r] = ((unsigned)(kc0 - cs_q) < 16u) ? p0[r] + brow[kc0] : -1e30f;
          p1[r] = ((unsigned)(kc1 - cs_q) < 16u) ? p1[r] + brow[kc1] : -1e30f; }
      }
      partialSM(p0, p1, m_reg, mn, al, SCALE);
      if (__any(al < 1.f)) { if (hi == 0) al_l[r32] = al; asm volatile("s_waitcnt lgkmcnt(0)" ::: "memory");
#pragma unroll
        for (int d = 0; d < 4; ++d)
#pragma unroll
          for (int r = 0; r < 16; ++r) o[d][r] *= al_l[crow(r, hi)]; }
      finishSM(p0, p1, al, l_reg, pa0, pa1, pa2, pa3); SBAR();
      pv_d0(o, vb0 + bb * SHM_V, pa0, pa1, pa2, pa3);
    }
    if (j + 1 < NT) { asm volatile("s_waitcnt vmcnt(0)" ::: "memory"); NA_WRITE(bb ^ 1); }
    __syncthreads();
  }
  if (hi == 0) li_l[r32] = l_reg; asm volatile("s_waitcnt lgkmcnt(0)" ::: "memory");
  float rli[16];
#pragma unroll
  for (int r = 0; r < 16; ++r) rli[r] = __builtin_amdgcn_rcpf(li_l[crow(r, hi)]);
  bf16_t* Ow = mix + (size_t)(qrow0 + wid * QBLK) * DM + 1536 + h * 128;
#pragma unroll
  for (int r = 0; r < 16; ++r) { const int orow = crow(r, hi);
#pragma unroll
    for (int d0 = 0; d0 < 4; ++d0) Ow[(size_t)orow * DM + d0 * 32 + r32] = f2bf(o[d0][r] * rli[r]); }
  __syncthreads();
#undef NA_TROW
#undef NA_LOAD
#undef NA_WRITE
}
}
DI void na_phase(const Frame& F, int l) {
    const bf16_t* p = (const bf16_t*)(F.big + WB_P); bf16_t* mix = (bf16_t*)(F.ws + WS_MIX);
    for (int u = F.wg; u < 8 * 33; u += F.nwg) { const int bh = u % 8, rq = (u < 8) ? 32 : (u - 8) / 8;
        att::na_body(p, F.in[I_RPB] + (size_t)(l * 4 + (bh & 3)) * 15 * 31, mix, bh >> 2, bh & 3, rq, (LAS char*)F.lds, F.tid); }
}
DI void na_naive(const Frame& F, int l) {
    const bf16_t* p = (const bf16_t*)(F.big + WB_P); bf16_t* mix = (bf16_t*)(F.ws + WS_MIX);
    float* qs = (float*)F.ldsg + F.wave * 512;
    float* ps = qs + 128;
    const int lane = F.lane; const float scale = 0.08838834764831845f;
    const float* rpb = F.in[I_RPB] + (size_t)l * 4 * 15 * 31;
    for (int it = F.gw; it < MT * 4; it += F.ngw) {
        const int r = it >> 2, h = it & 3; const RowInfo ri = row_info(r);
        const bf16_t* q = p + (size_t)r * NP + PC_NA + h * 128;
        { const unsigned w = *(const unsigned*)(q + 2 * lane); qs[2 * lane] = bflo(w); qs[2 * lane + 1] = bfhi(w); }
        asm volatile("s_waitcnt lgkmcnt(0)" ::: "memory");
        const int gr = ri.t >> 6, gc = ri.t & 63;
        const int rs = min(max(gr - 4, 0), 120), cs = min(max(gc - 8, 0), 48);
        const int nkeys = ri.ctx ? 256 : 384; const int nper = nkeys / 64;
#pragma unroll 1
        for (int i = 0; i < nper; ++i) {
            const int idx = lane + 64 * i; int krow; float bias = 0.f;
            if (!ri.ctx && idx < 128) { const int rr = rs + (idx >> 4), ck = cs + (idx & 15); krow = ri.b * SEQ + rr * 64 + ck; bias = rpb[(h * 15 + (rr - gr + 7)) * 31 + (ck - gc + 15)]; }
            else { krow = MLAT + ri.b * CTX + (ri.ctx ? idx : idx - 128); }
            const bf16_t* k = p + (size_t)krow * NP + PC_NA + 512 + h * 128; float d = 0.f;
#pragma unroll 4
            for (int c8 = 0; c8 < 16; ++c8) { float kf[8]; unpack8(*(const u32x4*)(k + c8 * 8), kf); const f32x4 q0 = *(const f32x4*)(qs + c8 * 8), q1 = *(const f32x4*)(qs + c8 * 8 + 4);
                d += kf[0] * q0[0] + kf[1] * q0[1] + kf[2] * q0[2] + kf[3] * q0[3] + kf[4] * q1[0] + kf[5] * q1[1] + kf[6] * q1[2] + kf[7] * q1[3]; }
            ps[idx] = d * scale + bias;
        }
        asm volatile("s_waitcnt lgkmcnt(0)" ::: "memory");
        float sc[6]; float mx = -1e30f;
#pragma unroll
        for (int i = 0; i < 6; ++i) { sc[i] = (i < nper) ? ps[lane + 64 * i] : -1e30f; mx = fmaxf(mx, sc[i]); }
        mx = wave_max(mx); float sum = 0.f;
#pragma unroll
        for (int i = 0; i < 6; ++i) { sc[i] = (i < nper) ? __expf(sc[i] - mx) : 0.f; sum += sc[i]; }
        sum = wave_sum(sum); const float inv = 1.f / sum;
#pragma unroll
        for (int i = 0; i < 6; ++i) if (i < nper) ps[lane + 64 * i] = sc[i] * inv;
        asm volatile("s_waitcnt lgkmcnt(0)" ::: "memory");
        float o0 = 0.f, o1 = 0.f;
#pragma unroll 4
        for (int idx = 0; idx < nkeys; ++idx) {
            int krow;
            if (!ri.ctx && idx < 128) krow = ri.b * SEQ + (rs + (idx >> 4)) * 64 + cs + (idx & 15); else krow = MLAT + ri.b * CTX + (ri.ctx ? idx : idx - 128);
            const unsigned w = *(const unsigned*)(p + (size_t)krow * NP + PC_NA + 1024 + h * 128 + 2 * lane); const float pr = ps[idx];
            o0 += pr * bflo(w); o1 += pr * bfhi(w);
        }
        *(unsigned*)(mix + (size_t)r * DM + 1536 + h * 128 + 2 * lane) = cvtpk(o0, o1);
        asm volatile("s_waitcnt lgkmcnt(0)" ::: "memory");
    }
}
namespace gdn {
DI unsigned off_b(unsigned row, unsigned ch) { return 256u * row + 16u * (ch ^ (((row & 3) << 2) | ((row >> 2) & 3))); }
DI unsigned tr_addr(unsigned lane, unsigned c, unsigned ks, unsigned t) { const unsigned h = lane >> 5, blk = (lane >> 4) & 1, q = (lane & 15) >> 2, p = lane & 3; return off_b(16 * ks + 8 * h + 4 * t + q, 4 * c + 2 * blk + (p >> 1)) + 8 * (p & 1); }
DI unsigned trD_addr(unsigned lane, unsigned c, unsigned rbase, unsigned g) { const unsigned h = lane >> 5, blk = (lane >> 4) & 1, q = (lane & 15) >> 2, p = lane & 3; return off_b(rbase + 8 * g + 4 * h + q, 4 * c + 2 * blk + (p >> 1)) + 8 * (p & 1); }
DI s16x4 trr(LAS unsigned char* base, unsigned off) { return __builtin_amdgcn_ds_read_tr16_b64_v4i16((LAS s16x4*)(base + off)); }
DI bf16x8 cat8(s16x4 a, s16x4 b) { return (bf16x8){a[0], a[1], a[2], a[3], b[0], b[1], b[2], b[3]}; }
DI bf16x8 pack8v(f32x4 a, f32x4 b) { u32x4 w; w.x = cvtpk(a[0], a[1]); w.y = cvtpk(a[2], a[3]); w.z = cvtpk(b[0], b[1]); w.w = cvtpk(b[2], b[3]); return __builtin_bit_cast(bf16x8, w); }
template <int SP> DI bf16x8 pack_step(const f32x16& x) { u32x4 w; w.x = cvtpk(x[8 * SP], x[8 * SP + 1]); w.y = cvtpk(x[8 * SP + 2], x[8 * SP + 3]); w.z = cvtpk(x[8 * SP + 4], x[8 * SP + 5]); w.w = cvtpk(x[8 * SP + 6], x[8 * SP + 7]); return __builtin_bit_cast(bf16x8, w); }
DI int crow(int r, int hi) { return (r & 3) + 8 * (r >> 2) + 4 * hi; }
#define GMFMA(a, b, c) __builtin_amdgcn_mfma_f32_32x32x16_bf16((a), (b), (c), 0, 0, 0)
struct Item { int dir, bh, b, h, r0, sgn; };
DI Item decode(int item) { Item I; I.dir = item / (8 * GDN_NCH); I.bh = (item / GDN_NCH) & 7; const int c = item % GDN_NCH; I.b = I.bh >> 2; I.h = I.bh & 3; I.sgn = I.dir ? -1 : 1;
    if (c < 4) { const int pos = 64 * c; I.r0 = MLAT + I.b * CTX + (I.dir ? CTX - 1 - pos : pos); } else { const int pos = 64 * (c - 4); I.r0 = I.b * SEQ + (I.dir ? SEQ - 1 - pos : pos); } return I; }

DI void chunk_phase(const Frame& F) {
    LAS unsigned char* L = F.lds; LAS unsigned char* Kimg = L; LAS unsigned char* Vimg = L + 16384; LAS float* As = (LAS float*)(L + 32768);
    LAS float* gs = (LAS float*)(L + 49152); LAS float* bs = gs + 64; LAS float* cw = gs + 128; LAS float* cu = gs + 192; LAS float* dg = gs + 256;
    const bf16_t* gqb = (const bf16_t*)(F.big + WB_GQB); const float* gate = (const float*)(F.big + WB_GATE);
    u32x4* Wf = (u32x4*)(F.ws + WG_WF); u32x4* Kf = (u32x4*)(F.ws + WG_KF); float* Uf = (float*)(F.ws + WG_UF); float* egl = (float*)(F.ws + WG_EGL); float* gtab = (float*)(F.ws + WG_GTAB);
    const int tid = F.tid, lane = F.lane, wave = F.wave, r32 = lane & 31, hi = lane >> 5;
    for (int item = F.wg; item < GDN_NITEM; item += F.nwg) {
        const Item I = decode(item);
#pragma unroll
        for (int u = 0; u < 2; ++u) { const int id = tid + 512 * u, row = id >> 4, ch = id & 15; const bf16_t* src = gqb + (size_t)(I.r0 + I.sgn * row) * 1536 + I.h * 128 + ch * 8;
            *(LAS u32x4*)(Kimg + off_b(row, ch)) = *(const u32x4*)(src + 512); *(LAS u32x4*)(Vimg + off_b(row, ch)) = *(const u32x4*)(src + 1024); }
        if (wave == 0) {
            const float* gr = gate + (size_t)(I.r0 + I.sgn * lane) * 16 + I.dir * 4 + I.h; const float la = gr[0], be = gr[8]; float g = la;
#pragma unroll
            for (int d = 1; d < 64; d <<= 1) { const float up = __int_as_float(__builtin_amdgcn_ds_bpermute((lane - d) << 2, __float_as_int(g))); if (lane >= d) g += up; }
            const float gl = __int_as_float(__builtin_amdgcn_readlane(__float_as_int(g), 63));
            gs[lane] = g; bs[lane] = be; cw[lane] = -be * __expf(g); cu[lane] = be; dg[lane] = __expf(gl - g); gtab[(size_t)item * 64 + lane] = g; if (lane == 0) egl[item] = __expf(gl);
        }
        __syncthreads();
        if (wave < 3) {
            const int it = wave > 0, jt = wave > 1; f32x16 acc = {};
#pragma unroll
            for (int s2 = 0; s2 < 8; ++s2) acc = GMFMA(*(const LAS bf16x8*)(Kimg + off_b(32 * it + r32, 2 * s2 + hi)), *(const LAS bf16x8*)(Kimg + off_b(32 * jt + r32, 2 * s2 + hi)), acc);
            const int j = 32 * jt + r32; const float gj = gs[j];
#pragma unroll
            for (int r = 0; r < 16; ++r) { const int i = 32 * it + crow(r, hi); As[i * 64 + j] = (i > j) ? bs[i] * acc[r] * __expf(gs[i] - gj) : 0.f; }
        } else if (wave == 3) {
#pragma unroll
            for (int r = 0; r < 16; ++r) As[(crow(r, hi)) * 64 + 32 + r32] = 0.f;
        }
        __syncthreads();
        if (wave == 0) {
            float T[64];
#pragma unroll
            for (int i = 0; i < 64; ++i) {
                float acc = (i == lane) ? 1.f : 0.f;
#pragma unroll
                for (int j4 = 0; j4 < (i + 3) / 4; ++j4) { const f32x4 a = *(const LAS f32x4*)(As + i * 64 + 4 * j4);
#pragma unroll
                    for (int e = 0; e < 4; ++e) if (4 * j4 + e < i) acc -= a[e] * T[4 * j4 + e]; }
                T[i] = acc; As[i * 64 + lane] = acc;
            }
        }
        __syncthreads();
        {
            const int tt = wave >> 1, mt = wave & 1; const int irow = 32 * mt + r32;
            f32x16 aw = {}, au = {};
#pragma unroll
            for (int ks = 0; ks < 4; ++ks) { if (mt == 0 && ks >= 2) continue;
                const int j0 = 16 * ks + 8 * hi; const f32x4 t0 = *(const LAS f32x4*)(As + irow * 64 + j0), t1 = *(const LAS f32x4*)(As + irow * 64 + j0 + 4);
                const bf16x8 tk = pack8v(t0 * *(const LAS f32x4*)(cw + j0), t1 * *(const LAS f32x4*)(cw + j0 + 4)), tv = pack8v(t0 * *(const LAS f32x4*)(cu + j0), t1 * *(const LAS f32x4*)(cu + j0 + 4));
                const bf16x8 kt = cat8(trr(Kimg, tr_addr(lane, tt, ks, 0)), trr(Kimg, tr_addr(lane, tt, ks, 1))), vt = cat8(trr(Vimg, tr_addr(lane, tt, ks, 0)), trr(Vimg, tr_addr(lane, tt, ks, 1)));
                aw = GMFMA(kt, tk, aw);
                au = GMFMA(tv, vt, au);
            }
            Wf[((size_t)item * 16 + (2 * tt + 0) * 2 + mt) * 64 + lane] = __builtin_bit_cast(u32x4, pack_step<0>(aw));
            Wf[((size_t)item * 16 + (2 * tt + 1) * 2 + mt) * 64 + lane] = __builtin_bit_cast(u32x4, pack_step<1>(aw));
            float* up = Uf + ((((size_t)item * 4 + tt) * 2 + mt) * 64 + lane) * 16;
#pragma unroll
            for (int q = 0; q < 4; ++q) *(f32x4*)(up + 4 * q) = (f32x4){au[4 * q], au[4 * q + 1], au[4 * q + 2], au[4 * q + 3]};
#pragma unroll
            for (int sp = 0; sp < 2; ++sp) {
                const bf16x8 raw = cat8(trr(Kimg, trD_addr(lane, tt, 32 * mt, 2 * sp)), trr(Kimg, trD_addr(lane, tt, 32 * mt, 2 * sp + 1)));
                const u32x4 rw = __builtin_bit_cast(u32x4, raw); const int t0i = 32 * mt + 16 * sp + 4 * hi; const f32x4 d0 = *(const LAS f32x4*)(dg + t0i), d1 = *(const LAS f32x4*)(dg + t0i + 8);
                u32x4 o; o.x = cvtpk(bflo(rw.x) * d0[0], bfhi(rw.x) * d0[1]); o.y = cvtpk(bflo(rw.y) * d0[2], bfhi(rw.y) * d0[3]); o.z = cvtpk(bflo(rw.z) * d1[0], bfhi(rw.z) * d1[1]); o.w = cvtpk(bflo(rw.w) * d1[2], bfhi(rw.w) * d1[3]);
                Kf[((size_t)item * 16 + tt * 4 + 2 * mt + sp) * 64 + lane] = o;
            }
        }
        __syncthreads();
    }
}

DI void scan_phase(const Frame& F) {
    if (F.wg >= 16) return;
    LAS unsigned char* L = F.lds;
    const u32x4* Wf = (const u32x4*)(F.ws + WG_WF); const u32x4* Kf = (const u32x4*)(F.ws + WG_KF); const float* Uf = (const float*)(F.ws + WG_UF); const float* egl = (const float*)(F.ws + WG_EGL);
    u32x4* Sf = (u32x4*)(F.ws + WH_SF); u32x4* Vf = (u32x4*)(F.ws + WG_VF);
    const int tid = F.tid, lane = F.lane, w = F.wave; const int item0 = F.wg * GDN_NCH;
    f32x16 S[4] = {}; f32x16 U[2] = {}; u32x4 st[4];
#define GS_LOAD(it_) do { _Pragma("unroll") for (int u_ = 0; u_ < 4; ++u_) { const int id_ = tid + 512 * u_; st[u_] = id_ < 1024 ? Wf[(size_t)(it_) * 1024 + id_] : Kf[(size_t)(it_) * 1024 + id_ - 1024]; } } while (0)
#define GS_STORE(b_) do { _Pragma("unroll") for (int u_ = 0; u_ < 4; ++u_) *(LAS u32x4*)(L + (b_) * 32768 + (tid + 512 * u_) * 16) = st[u_]; } while (0)
#define GS_LOADU(dst, it_) do { if (w < 4) { _Pragma("unroll") for (int mt_ = 0; mt_ < 2; ++mt_) { const float* up_ = Uf + ((((size_t)(it_) * 4 + w) * 2 + mt_) * 64 + lane) * 16; \
        _Pragma("unroll") for (int q_ = 0; q_ < 4; ++q_) { const f32x4 v_ = *(const f32x4*)(up_ + 4 * q_); dst[mt_][4 * q_] = v_[0]; dst[mt_][4 * q_ + 1] = v_[1]; dst[mt_][4 * q_ + 2] = v_[2]; dst[mt_][4 * q_ + 3] = v_[3]; } } } } while (0)
    GS_LOAD(item0); GS_LOADU(U, item0); GS_STORE(0); __syncthreads();
#pragma unroll 1
    for (int c = 0; c < GDN_NCH; ++c) {
        const int item = item0 + c; const bool more = c + 1 < GDN_NCH; f32x16 Un[2] = {};
        if (more) { GS_LOAD(item + 1); GS_LOADU(Un, item + 1); }
        if (w < 4) {
            const LAS unsigned char* buf = L + (c & 1) * 32768; const float eg = egl[item];
            bf16x8 Bs[8];
            Bs[0] = pack_step<0>(S[0]); Bs[1] = pack_step<1>(S[0]); Bs[2] = pack_step<0>(S[1]); Bs[3] = pack_step<1>(S[1]);
            Bs[4] = pack_step<0>(S[2]); Bs[5] = pack_step<1>(S[2]); Bs[6] = pack_step<0>(S[3]); Bs[7] = pack_step<1>(S[3]);
#pragma unroll
            for (int f = 0; f < 8; ++f) Sf[(((size_t)item * 4 + w) * 8 + f) * 64 + lane] = __builtin_bit_cast(u32x4, Bs[f]);
            f32x16 acc0 = U[0], acc1 = U[1];
#pragma unroll
            for (int ks = 0; ks < 8; ++ks) { acc0 = GMFMA(*(const LAS bf16x8*)(buf + ((ks * 2 + 0) * 64 + lane) * 16), Bs[ks], acc0); acc1 = GMFMA(*(const LAS bf16x8*)(buf + ((ks * 2 + 1) * 64 + lane) * 16), Bs[ks], acc1); }
            bf16x8 vf[4]; vf[0] = pack_step<0>(acc0); vf[1] = pack_step<1>(acc0); vf[2] = pack_step<0>(acc1); vf[3] = pack_step<1>(acc1);
#pragma unroll
            for (int f = 0; f < 4; ++f) Vf[(((size_t)item * 4 + w) * 4 + f) * 64 + lane] = __builtin_bit_cast(u32x4, vf[f]);
#pragma unroll
            for (int tt = 0; tt < 4; ++tt) { S[tt] = S[tt] * eg;
#pragma unroll
                for (int ks = 0; ks < 4; ++ks) S[tt] = GMFMA(*(const LAS bf16x8*)(buf + 16384 + ((tt * 4 + ks) * 64 + lane) * 16), vf[ks], S[tt]); }
        }
        if (more) { GS_STORE((c + 1) & 1); U[0] = Un[0]; U[1] = Un[1]; }
        __syncthreads();
    }
#undef GS_LOAD
#undef GS_STORE
#undef GS_LOADU
}

DI void out_phase(const Frame& F, float* og) {
    LAS unsigned char* L = F.lds; LAS unsigned char* Qimg = L; LAS unsigned char* Kimg = L + 16384; LAS float* gs = (LAS float*)(L + 32768);
    const bf16_t* gqb = (const bf16_t*)(F.big + WB_GQB); const float* gtab = (const float*)(F.ws + WG_GTAB);
    const u32x4* Sf = (const u32x4*)(F.ws + WH_SF); const u32x4* Vf = (const u32x4*)(F.ws + WG_VF);
    const int tid = F.tid, lane = F.lane, wave = F.wave, r32 = lane & 31, hi = lane >> 5;
    for (int item = F.wg; item < GDN_NITEM; item += F.nwg) {
        const Item I = decode(item);
#pragma unroll
        for (int u = 0; u < 2; ++u) { const int id = tid + 512 * u, row = id >> 4, ch = id & 15; const bf16_t* src = gqb + (size_t)(I.r0 + I.sgn * row) * 1536 + I.h * 128 + ch * 8;
            *(LAS u32x4*)(Qimg + off_b(row, ch)) = *(const u32x4*)(src); *(LAS u32x4*)(Kimg + off_b(row, ch)) = *(const u32x4*)(src + 512); }
        if (wave == 0) gs[lane] = gtab[(size_t)item * 64 + lane];
        __syncthreads();
        const int mt = wave & 1, dvb = wave >> 1; const int trow = 32 * mt + r32;
        f32x16 a1 = {}, a2 = {};
#pragma unroll
        for (int ks = 0; ks < 8; ++ks) {
            const bf16x8 qa = cat8(*(const LAS s16x4*)(Qimg + off_b(trow, 2 * ks) + 8 * hi), *(const LAS s16x4*)(Qimg + off_b(trow, 2 * ks + 1) + 8 * hi));
            a1 = GMFMA(qa, __builtin_bit_cast(bf16x8, Sf[(((size_t)item * 4 + dvb) * 8 + ks) * 64 + lane]), a1);
        }
        const float gt = gs[trow];
#pragma unroll
        for (int jt = 0; jt < 2; ++jt) { if (jt > mt) continue;
            f32x16 m = {};
#pragma unroll
            for (int s2 = 0; s2 < 8; ++s2) m = GMFMA(*(const LAS bf16x8*)(Kimg + off_b(32 * jt + r32, 2 * s2 + hi)), *(const LAS bf16x8*)(Qimg + off_b(trow, 2 * s2 + hi)), m);
#pragma unroll
            for (int r = 0; r < 16; ++r) { const int j = 32 * jt + crow(r, hi); m[r] = (trow >= j) ? m[r] * __expf(gt - gs[j]) : 0.f; }
            a2 = GMFMA(pack_step<0>(m), __builtin_bit_cast(bf16x8, Vf[(((size_t)item * 4 + dvb) * 4 + 2 * jt + 0) * 64 + lane]), a2);
            a2 = GMFMA(pack_step<1>(m), __builtin_bit_cast(bf16x8, Vf[(((size_t)item * 4 + dvb) * 4 + 2 * jt + 1) * 64 + lane]), a2);
        }
#pragma unroll
        for (int r = 0; r < 16; ++r) { const int t = 32 * mt + crow(r, hi);
            og[((size_t)I.dir * MT + (I.r0 + I.sgn * t)) * 512 + I.h * 128 + 32 * dvb + r32] = __expf(gs[t]) * a1[r] + a2[r]; }
        __syncthreads();
    }
}
#undef GMFMA
}
DI void mixer_post(const Frame& F, int l) {
    const bf16_t* p = (const bf16_t*)(F.big + WB_P); const float* og = (const float*)(F.big + WB_OG); const float* Od = (const float*)(F.big + WB_OD); bf16_t* mix = (bf16_t*)(F.ws + WS_MIX);
    const int lane = F.lane; const int c0 = lane * 8, d0 = (lane & 15) * 8;
    const float lam_init = 0.8f - 0.6f * __expf(-0.3f * (float)l);
    float lam; { const float* lf = F.in[I_DLAM] + l * 256; float s1 = wave_sum(lf[lane] * lf[64 + lane]), s2 = wave_sum(lf[128 + lane] * lf[192 + lane]); lam = expf(s1) - expf(s2) + lam_init; }
    const float* gn = F.in[I_GNORM] + l * 128 + d0; const float* dn = F.in[I_DNORM] + l * 128 + d0;
    for (int r = F.gw; r < MT; r += F.ngw) {
        {
            const float* a = og + (size_t)r * 512 + c0; const float* bq = og + ((size_t)MT + r) * 512 + c0; float o[8], z[8]; float ss = 0.f;
            const f32x4 a0 = *(const f32x4*)a, a1 = *(const f32x4*)(a + 4), b0 = *(const f32x4*)bq, b1 = *(const f32x4*)(bq + 4);
#pragma unroll
            for (int j = 0; j < 4; ++j) { o[j] = a0[j] + b0[j]; o[4 + j] = a1[j] + b1[j]; }
#pragma unroll
            for (int j = 0; j < 8; ++j) ss += o[j] * o[j];
            ss = grp16_sum(ss); const float rs = rsqrtf(ss * (1.f / 128.f) + RMS_EPS);
            unpack8(*(const u32x4*)(p + (size_t)r * NP + PC_GZ + c0), z);
#pragma unroll
            for (int j = 0; j < 8; ++j) o[j] = o[j] * rs * gn[j] * silu_f(z[j]);
            *(u32x4*)(mix + (size_t)r * DM + c0) = pack8(o);
        }
        {
            const float* a = Od + (size_t)r * 512 + c0; const float* bq = Od + ((size_t)MT + r) * 512 + c0; float o[8]; float ss = 0.f;
            const f32x4 a0 = *(const f32x4*)a, a1 = *(const f32x4*)(a + 4), b0 = *(const f32x4*)bq, b1 = *(const f32x4*)(bq + 4);
#pragma unroll
            for (int j = 0; j < 4; ++j) { o[j] = a0[j] - lam * b0[j]; o[4 + j] = a1[j] - lam * b1[j]; }
#pragma unroll
            for (int j = 0; j < 8; ++j) ss += o[j] * o[j];
            ss = grp16_sum(ss); const float rs = rsqrtf(ss * (1.f / 128.f) + RMS_EPS) * (1.f - lam_init);
#pragma unroll
            for (int j = 0; j < 8; ++j) o[j] = o[j] * rs * dn[j];
            *(u32x4*)(mix + (size_t)r * DM + 512 + c0) = pack8(o);
        }
    }
}
DI void ln_phase(const Frame& F, int l, int which) {
    const float* y = (const float*)(F.big + WB_Y); float* xbuf = (float*)(F.ws + WS_XBUF); bf16_t* hb = (bf16_t*)(F.ws + WS_H);
    const float* lg = F.in[I_LNG] + (size_t)(l * 2 + which) * DM; const float* lb = F.in[I_LNB] + (size_t)(l * 2 + which) * DM;
    const bool first = (l == 0 && which == 0), lastl = (l == DEPTH - 1 && which == 1);
    const int lane = F.lane;
    for (int r = F.gw; r < MT; r += F.ngw) {
        const RowInfo ri = row_info(r);
        const float* x = first ? x_row_in(F, r) : xbuf + (size_t)r * DM; const float* yr = y + (size_t)r * DM;
        const float* mA = modv(F, l, ri.mr, which == 0 ? 2 : 5);
        float z[32]; float s = 0.f;
#pragma unroll
        for (int i = 0; i < 8; ++i) { const int c = (i * 64 + lane) * 4; const f32x4 xv = *(const f32x4*)(x + c), yv = *(const f32x4*)(yr + c), mv = *(const f32x4*)(mA + c);
#pragma unroll
            for (int j = 0; j < 4; ++j) { z[i * 4 + j] = DN_ALPHA * xv[j] + mv[j] * yv[j]; s += z[i * 4 + j]; } }
        s = wave_sum(s); const float mu = s * (1.f / DM); float q = 0.f;
#pragma unroll
        for (int i = 0; i < 32; ++i) { const float d = z[i] - mu; q += d * d; }
        q = wave_sum(q); const float rstd = rsqrtf(q * (1.f / DM) + LN_EPS);
        const float* mS = nullptr; const float* mT = nullptr;
        if (which == 0) { mT = modv(F, l, ri.mr, 3); mS = modv(F, l, ri.mr, 4); } else if (!lastl) { mT = modv(F, l + 1, ri.mr, 0); mS = modv(F, l + 1, ri.mr, 1); }
        float* xo = (lastl && r < MLAT) ? F.out + (size_t)r * DM : xbuf + (size_t)r * DM;
#pragma unroll
        for (int i = 0; i < 8; ++i) { const int c = (i * 64 + lane) * 4; const f32x4 gv = *(const f32x4*)(lg + c), bv = *(const f32x4*)(lb + c); f32x4 xn;
#pragma unroll
            for (int j = 0; j < 4; ++j) xn[j] = (z[i * 4 + j] - mu) * rstd * gv[j] + bv[j];
            *(f32x4*)(xo + c) = xn;
            if (mS) { const f32x4 sv = *(const f32x4*)(mS + c), tv = *(const f32x4*)(mT + c);
                u32x2 w; w.x = cvtpk(xn[0] * (1.f + sv[0]) + tv[0], xn[1] * (1.f + sv[1]) + tv[1]); w.y = cvtpk(xn[2] * (1.f + sv[2]) + tv[2], xn[3] * (1.f + sv[3]) + tv[3]);
                *(u32x2*)(hb + (size_t)r * DM + c) = w; } }
    }
}
DI void ffn_convact(const Frame& F, int l) {
    const bf16_t* u = (const bf16_t*)(F.big + WB_U); bf16_t* g = (bf16_t*)(F.ws + WS_G);
    const float* cw = F.in[I_FCONV] + (size_t)l * 3 * NUP;
    constexpr int CPRW = DFF / 8;
    for (size_t it = (size_t)F.wg * NTHREADS + F.tid; it < (size_t)MT * CPRW; it += (size_t)F.nwg * NTHREADS) {
        const int r = (int)(it / CPRW), c0 = (int)(it % CPRW) * 8; const RowInfo ri = row_info(r);
        const bool hasm = ri.t > 0, hasn = ri.t < ri.len - 1; const bf16_t* ur = u + (size_t)r * NUP;
        float o[8];
        float gc[8], gm[8], gn[8], vc[8], vm[8], vn[8];
        unpack8(*(const u32x4*)(ur + c0), gc); unpack8(*(const u32x4*)(ur + DFF + c0), vc);
        if (hasm) { unpack8(*(const u32x4*)(ur - NUP + c0), gm); unpack8(*(const u32x4*)(ur - NUP + DFF + c0), vm); } else { for (int j = 0; j < 8; ++j) { gm[j] = 0.f; vm[j] = 0.f; } }
        if (hasn) { unpack8(*(const u32x4*)(ur + NUP + c0), gn); unpack8(*(const u32x4*)(ur + NUP + DFF + c0), vn); } else { for (int j = 0; j < 8; ++j) { gn[j] = 0.f; vn[j] = 0.f; } }
#pragma unroll
        for (int j = 0; j < 8; ++j) {
            const float ga = cw[c0 + j] * gm[j] + cw[NUP + c0 + j] * gc[j] + cw[2 * NUP + c0 + j] * gn[j];
            const float va = cw[DFF + c0 + j] * vm[j] + cw[NUP + DFF + c0 + j] * vc[j] + cw[2 * NUP + DFF + c0 + j] * vn[j];
            o[j] = silu_f(ga) * va; }
        *(u32x4*)(g + (size_t)r * DFF + c0) = pack8(o);
    }
}

constexpr int NPRO = 3, NPH = 16;
__global__ void __launch_bounds__(NTHREADS, 2) fwd(Args a) {
    extern __shared__ __attribute__((aligned(16))) unsigned char lds_raw[];
#define FR() Frame F; { unsigned z_ = 0u; asm volatile("; launder zero" : "+v"(z_)); int w0_ = wave0; asm volatile("; launder wave" : "+s"(w0_)); int t_ = w0_ * 64 + (int)__builtin_amdgcn_mbcnt_hi(~0u, __builtin_amdgcn_mbcnt_lo(~0u, z_)); int w_ = blockIdx.x; asm volatile("; launder wg" : "+s"(w_)); unsigned char* ws_ = a.ws; asm volatile("; launder ws" : "+s"(ws_)); \
    F.in = a.in; F.out = a.out; F.ws = ws_; F.big = ws_ + WS_BIG; \
    F.lds = (LAS unsigned char*)lds_raw; F.ldsg = (char*)lds_raw; F.tid = t_; F.lane = t_ & 63; F.wave = __builtin_amdgcn_readfirstlane(t_ >> 6); F.wg = w_; F.nwg = gridDim.x; F.gw = F.wg * NWAVES + F.wave; F.ngw = F.nwg * NWAVES; }
    LAS unsigned char* lds0 = (LAS unsigned char*)lds_raw;
    const int wave0 = __builtin_amdgcn_readfirstlane(threadIdx.x >> 6);
    volatile LAS unsigned* xbw = (volatile LAS unsigned*)(lds0 + LDS_BYTES - 16);
    if (threadIdx.x == 0) { xbw[0] = 0u; xbw[1] = 0u; xbw[2] = 0u; xbw[3] = 0u; }
    __syncthreads();
    XcdBarrier bar; bar.bar = (unsigned*)(a.ws + WS_CTL); bar.x = 0; bar.st = xbw;
    if (a.fused) bar = xcd_barrier_post((unsigned*)(a.ws + WS_CTL), xbw);
#define SEAM() do { if (a.fused) xcd_barrier(bar); } while (0)
#ifndef ONLY
#define ONLY -1
#endif
#define PIN(k) ((ONLY < 0 || ONLY == 100 + (k)) && a.pro_lo <= (k) && (k) < a.pro_hi)
#define IN(k) ((ONLY < 0 || ONLY == (k)) && a.ph_lo <= (k) && (k) < a.ph_hi)
#define RP(k) for (int rp_ = 0; rp_ < ((k) == REP_PHASE ? REP_COUNT : 1); ++rp_)
    if (PIN(0)) { { FR(); convert_layer(F, 0); pro_gemv(F); } SEAM(); }
    if (PIN(1)) { { FR(); pro_modreduce(F); } SEAM(); }
    if (PIN(2)) { { FR(); pro_h0(F); } SEAM(); }
    for (int l = a.l_lo; l < a.l_hi; ++l) {
        if (IN(0)) {
            RP(0) { FR();
            pg8::Gemm g{(const bf16_t*)(F.ws + WS_H), (const bf16_t*)(F.ws + WS_WIN), MT, NP, DM}; pg8::StaticOrder S; S.init(MT, NP, F.nwg, F.wg);
            pg8::EpiBf16 E{(bf16_t*)(F.big + WB_P), NP}; pg8::gemm_phase(F.lds, g, S, E, F.tid); } SEAM(); }
        if (IN(1)) { RP(1) { FR(); prep_rows(F, l); } SEAM(); }
        if (IN(2)) {
            RP(2) { FR();
#pragma unroll 1
            for (int s2 = 0; s2 < 2; ++s2) {
                const bf16_t* Ap = (const bf16_t*)(F.big + (s2 ? WB_CKV : WB_CQ)); const bf16_t* Bp = (const bf16_t*)(F.ws + (s2 ? WS_WUKV : WS_WUQ));
                const int Ng = s2 ? 1024 : 768, Kg = s2 ? 256 : 384;
                pg8::Gemm g{Ap, Bp, MT, Ng, Kg}; pg8::StaticOrder S; S.init(MT, Ng, F.nwg, F.wg);
                pg8::EpiBf16 E{(bf16_t*)(F.big + (s2 ? WB_KVRAW : WB_QRAW)), Ng}; pg8::gemm_phase(F.lds, g, S, E, F.tid);
            }
            } SEAM(); }
        if (IN(3)) { RP(3) { FR(); gdn::chunk_phase(F); mla_assemble(F); } SEAM(); }
        if (IN(4)) { RP(4) { FR(); attn_diff_phase(F); } SEAM(); }
        if (IN(5)) { RP(5) { FR(); attn_mla_phase(F); } SEAM(); }
        if (IN(6)) { RP(6) { FR(); na_phase(F, l); } SEAM(); }
        if (IN(7)) { RP(7) { FR(); gdn::scan_phase(F); } SEAM(); }
        if (IN(15)) { RP(15) { FR(); gdn::out_phase(F, (float*)(F.big + WB_OG)); } SEAM(); }
        if (IN(8)) { RP(8) { FR(); mixer_post(F, l); } SEAM(); }
        if (IN(9)) {
            RP(9) { FR();
            pg8::Gemm g{(const bf16_t*)(F.ws + WS_MIX), (const bf16_t*)(F.ws + WS_WOUT), MT, DM, DM}; pg8::StaticOrder S; S.init(MT, DM, F.nwg, F.wg);
            pg8::EpiF32 E{(float*)(F.big + WB_Y), DM}; pg8::gemm_phase(F.lds, g, S, E, F.tid); } SEAM(); }
        if (IN(10)) { RP(10) { FR(); ln_phase(F, l, 0); } SEAM(); }
        if (IN(11)) {
            RP(11) { FR();
            pg8::Gemm g{(const bf16_t*)(F.ws + WS_H), (const bf16_t*)(F.ws + WS_WUP), MT, NUP, DM}; pg8::StaticOrder S; S.init(MT, NUP, F.nwg, F.wg);
            pg8::EpiBf16 E{(bf16_t*)(F.big + WB_U), NUP}; pg8::gemm_phase(F.lds, g, S, E, F.tid); } SEAM(); }
        if (IN(12)) { RP(12) { FR(); ffn_convact(F, l); } SEAM(); }
        if (IN(13)) {
            RP(13) { FR();
            pg8::Gemm g{(const bf16_t*)(F.ws + WS_G), (const bf16_t*)(F.ws + WS_WDN), MT, DM, DFF}; pg8::StaticOrder S; S.init(MT, DM, F.nwg, F.wg);
            pg8::EpiF32 E{(float*)(F.big + WB_Y2), DM}; pg8::gemm_phase(F.lds, g, S, E, F.tid); } SEAM(); }
        if (IN(14)) { RP(14) { FR(); ln_phase(F, l, 1); if (l + 1 < DEPTH) convert_layer(F, l + 1); } if (l + 1 < a.l_hi) SEAM(); }
    }
#undef SEAM
#undef PIN
#undef IN
}

extern "C" void kernel_launch(void* const* d_in, const int* in_sizes, int n_in, void* d_out, int out_size, void* d_ws, size_t ws_size, hipStream_t stream) {
    static int grid = 0;
    if (grid == 0) {
        if (n_in != N_INPUTS || out_size != MLAT * DM || ws_size < WS_END) { fprintf(stderr, "kernel_launch: unexpected shapes: n_in %d out %d ws %zu (need %zu)\n", n_in, out_size, ws_size, (size_t)WS_END); grid = -1; return; }
        int dev = 0, cus = 0, per_cu = 0;
        if (hipGetDevice(&dev) != hipSuccess || hipDeviceGetAttribute(&cus, hipDeviceAttributeMultiprocessorCount, dev) != hipSuccess) { grid = -1; return; }
        if (hipFuncSetAttribute((const void*)fwd, hipFuncAttributeMaxDynamicSharedMemorySize, LDS_BYTES) != hipSuccess) { fprintf(stderr, "kernel_launch: hipFuncSetAttribute failed\n"); grid = -1; return; }
        if (hipOccupancyMaxActiveBlocksPerMultiprocessor(&per_cu, (const void*)fwd, NTHREADS, LDS_BYTES) != hipSuccess || per_cu < 1) { fprintf(stderr, "kernel_launch: occupancy query says %d\n", per_cu); }
        (void)hipGetLastError();
        grid = cus;
    }
    if (grid < 0) return;
    (void)hipMemsetAsync((char*)d_ws + WS_CTL, 0, CTL_BYTES, stream);
    Args a{};
    for (int i = 0; i < N_INPUTS; ++i) a.in[i] = (const float*)d_in[i];
    a.out = (float*)d_out; a.ws = (unsigned char*)d_ws; a.pad = 0;
#if MK_FUSED
    a.pro_lo = 0; a.pro_hi = NPRO; a.l_lo = 0; a.l_hi = DEPTH; a.ph_lo = 0; a.ph_hi = NPH; a.fused = 1;
    hipLaunchKernelGGL(fwd, dim3(grid), dim3(NTHREADS), LDS_BYTES, stream, a);
#else
    a.fused = 0;
    for (int k = 0; k < NPRO; ++k) { a.pro_lo = k; a.pro_hi = k + 1; a.l_lo = 0; a.l_hi = 0; a.ph_lo = 0; a.ph_hi = 0; hipLaunchKernelGGL(fwd, dim3(grid), dim3(NTHREADS), LDS_BYTES, stream, a); }
    a.pro_lo = 0; a.pro_hi = 0;
    for (int l = 0; l < DEPTH; ++l) for (int k = 0; k < NPH; ++k) { a.l_lo = l; a.l_hi = l + 1; a.ph_lo = k; a.ph_hi = k + 1; hipLaunchKernelGGL(fwd, dim3(grid), dim3(NTHREADS), LDS_BYTES, stream, a); }
#endif
    const hipError_t le = hipPeekAtLastError();
    if (le != hipSuccess) fprintf(stderr, "kernel_launch: launch failed: %s\n", hipGetErrorName(le));
}
```
